# Optimizing an MI355X kernel written in HIP

```python
import jax, jax.numpy as jnp
from jax import lax
import numpy as np

D_MODEL = 1024
BATCH = 4
SEQ = 4096
DEPTH = 4

HEAD_DIM = 64
FOX_HEADS = 8
SB_HEADS = 4
POOL_GROUPS = 4
POOL_WINDOWS = (2, 4, 8, 16)
POOL_GROUP_DIM = 64
FOX_W = FOX_HEADS * HEAD_DIM
SB_W = SB_HEADS * HEAD_DIM
POOL_W = POOL_GROUPS * POOL_GROUP_DIM
D_MIX = FOX_W + POOL_W + SB_W
Q_BLOCK = 128
EPS = 1e-6
NEG = -1e30

IN_SPLITS = (
    FOX_W, FOX_W, FOX_W, FOX_W,
    FOX_HEADS,
    POOL_W, POOL_W,
    SB_W, SB_W, SB_W, SB_W,
)
D_IN = sum(IN_SPLITS)

kernel_name = "hybrid_fox_pool_stickbreak_parallel_heads"


def rms_norm(x, g):
    xf = x.astype(jnp.float32)
    y = xf * lax.rsqrt(jnp.mean(xf * xf, axis=-1, keepdims=True) + EPS)
    return (y * g.astype(jnp.float32)).astype(x.dtype)


def to_heads(t, n_heads):
    b, s, _ = t.shape
    return t.reshape(b, s, n_heads, HEAD_DIM).transpose(0, 2, 1, 3)


def from_heads(t):
    b, h, s, d = t.shape
    return t.transpose(0, 2, 1, 3).reshape(b, s, h * d)


def split_blocks(t):
    b, h, s = t.shape[:3]
    nb = s // Q_BLOCK
    t = t.reshape((b, h, nb, Q_BLOCK) + t.shape[3:])
    return jnp.moveaxis(t, 2, 0)


def merge_blocks(o):
    nb, b, h, qb, d = o.shape
    return jnp.moveaxis(o, 0, 2).reshape(b, h, nb * qb, d)


def forgetting_attention(q, k, v, log_f):
    s_len, d = q.shape[2], q.shape[3]
    c = jnp.cumsum(log_f, axis=-1)
    kpos = jnp.arange(s_len)
    scale = d ** -0.5

    def one_block(args):
        qi, ci, i = args
        qpos = i * Q_BLOCK + jnp.arange(Q_BLOCK)
        sc = jnp.einsum('bhqd,bhkd->bhqk', qi, k).astype(jnp.float32) * scale
        sc = sc + (ci[..., :, None] - c[..., None, :])
        sc = jnp.where(kpos[None, :] <= qpos[:, None], sc, NEG)
        p = jax.nn.softmax(sc, axis=-1)
        return jnp.einsum('bhqk,bhkd->bhqd', p.astype(v.dtype), v)

    nb = s_len // Q_BLOCK
    o = lax.map(one_block, (split_blocks(q), split_blocks(c), jnp.arange(nb)))
    return merge_blocks(o)


def stick_breaking_attention(q, k, v):
    s_len, d = q.shape[2], q.shape[3]
    kpos = jnp.arange(s_len)
    scale = d ** -0.5

    def one_block(args):
        qi, i = args
        qpos = i * Q_BLOCK + jnp.arange(Q_BLOCK)
        z = jnp.einsum('bhqd,bhkd->bhqk', qi, k).astype(jnp.float32) * scale
        causal = kpos[None, :] < qpos[:, None]
        log_1m_beta = jnp.where(causal, -jax.nn.softplus(z), 0.0)
        rest = lax.cumsum(log_1m_beta, axis=3, reverse=True) - log_1m_beta
        a = jnp.where(causal, jnp.exp(jax.nn.log_sigmoid(z) + rest), 0.0)
        return jnp.einsum('bhqk,bhkd->bhqd', a.astype(v.dtype), v)

    nb = s_len // Q_BLOCK
    o = lax.map(one_block, (split_blocks(q), jnp.arange(nb)))
    return merge_blocks(o)


def causal_window_mean(x, w):
    s_len = x.shape[1]
    xf = x.astype(jnp.float32)
    cs = jnp.cumsum(xf, axis=1)
    cs_prev = jnp.pad(cs, ((0, 0), (w, 0), (0, 0)))[:, :s_len]
    count = jnp.minimum(jnp.arange(s_len) + 1, w).astype(jnp.float32)
    return ((cs - cs_prev) / count[None, :, None]).astype(x.dtype)


def multiscale_pool(x, w_pool, scale):
    b, s_len, _ = x.shape
    groups = jnp.split(x, POOL_GROUPS, axis=-1)
    pooled = jnp.stack([causal_window_mean(g, w) - g for g, w in zip(groups, POOL_WINDOWS)], axis=2)
    y = jnp.einsum('bsgc,gcd->bsgd', pooled, w_pool).reshape(b, s_len, POOL_W)
    return y * scale


def hybrid_layer(x, norm_g, w_in, b_f, q_norm_g, k_norm_g, w_pool, pool_scale, w_out):
    h = rms_norm(x, norm_g)
    proj = jnp.einsum('bsd,de->bse', h, w_in)
    idx = np.cumsum(IN_SPLITS)[:-1].tolist()
    (fq, fk, fv, fg, ff, px, pg, sq, sk, sv, sg) = jnp.split(proj, idx, axis=-1)

    fq = rms_norm(to_heads(fq, FOX_HEADS), q_norm_g)
    fk = rms_norm(to_heads(fk, FOX_HEADS), k_norm_g)
    fv = to_heads(fv, FOX_HEADS)
    log_f = jax.nn.log_sigmoid((ff + b_f).astype(jnp.float32)).transpose(0, 2, 1)
    fox_out = from_heads(forgetting_attention(fq, fk, fv, log_f)) * jax.nn.silu(fg)

    pool_out = multiscale_pool(px, w_pool, pool_scale) * jax.nn.silu(pg)

    sb = stick_breaking_attention(to_heads(sq, SB_HEADS), to_heads(sk, SB_HEADS), to_heads(sv, SB_HEADS))
    sb_out = from_heads(sb) * jax.nn.silu(sg)

    mixed = jnp.concatenate([fox_out, pool_out, sb_out], axis=-1)
    return x + jnp.einsum('bse,ed->bsd', mixed, w_out)


def setup_inputs(seed: int = 0) -> dict:
    key = jax.random.key(seed)
    ks = jax.random.split(key, 10)
    x = jax.random.normal(ks[0], (BATCH, SEQ, D_MODEL), jnp.float32)
    norm_g = 1.0 + 0.02 * jax.random.normal(ks[1], (DEPTH, D_MODEL), jnp.float32)
    w_in = jax.random.normal(ks[2], (DEPTH, D_MODEL, D_IN), jnp.float32) * D_MODEL ** -0.5
    b_f = jax.random.uniform(ks[3], (DEPTH, FOX_HEADS), jnp.float32, 1.0, 4.0)
    q_norm_g = 1.0 + 0.02 * jax.random.normal(ks[4], (DEPTH, HEAD_DIM), jnp.float32)
    k_norm_g = 1.0 + 0.02 * jax.random.normal(ks[5], (DEPTH, HEAD_DIM), jnp.float32)
    w_pool = jax.random.normal(ks[6], (DEPTH, POOL_GROUPS, POOL_GROUP_DIM, POOL_GROUP_DIM), jnp.float32) * POOL_GROUP_DIM ** -0.5
    pool_scale = 1.0 + 0.02 * jax.random.normal(ks[7], (DEPTH, POOL_W), jnp.float32)
    w_out = jax.random.normal(ks[8], (DEPTH, D_MIX, D_MODEL), jnp.float32) * D_MIX ** -0.5
    return {"x": x, "norm_g": norm_g, "w_in": w_in, "b_f": b_f, "q_norm_g": q_norm_g,
            "k_norm_g": k_norm_g, "w_pool": w_pool, "pool_scale": pool_scale, "w_out": w_out}


def reference(x, norm_g, w_in, b_f, q_norm_g, k_norm_g, w_pool, pool_scale, w_out):
    for l in range(DEPTH):
        x = hybrid_layer(x, norm_g[l], w_in[l], b_f[l], q_norm_g[l], k_norm_g[l],
                         w_pool[l], pool_scale[l], w_out[l])
    return x
```

```cpp
#include <hip/hip_runtime.h>
#include <hip/hip_cooperative_groups.h>
#include <cstdint>
#include <cstdio>
namespace cg = cooperative_groups;

#ifndef SB_EARLY_EXIT
#define SB_EARLY_EXIT 1
#endif
#ifndef FOX_SKIP
#define FOX_SKIP 1
#endif
#define DI __device__ __forceinline__
#define LAS __attribute__((address_space(3)))
typedef short bf16x8 __attribute__((ext_vector_type(8)));
typedef float f32x16 __attribute__((ext_vector_type(16)));
typedef float f32x4 __attribute__((ext_vector_type(4)));
typedef float f32x2 __attribute__((ext_vector_type(2)));
typedef unsigned u32x4 __attribute__((ext_vector_type(4)));
typedef unsigned u32x2 __attribute__((ext_vector_type(2)));
typedef __bf16 bf2_t __attribute__((ext_vector_type(2)));
#define MFMA32(a, b, c) __builtin_amdgcn_mfma_f32_32x32x16_bf16((a), (b), (c), 0, 0, 0)
#define PIN8(a) asm volatile("" : "+v"(a[0][0]), "+v"(a[0][1]), "+v"(a[0][2]), "+v"(a[0][3]), "+v"(a[1][0]), "+v"(a[1][1]), "+v"(a[1][2]), "+v"(a[1][3]))

constexpr int NB = 4, S = 4096, DM = 1024, NL = 4, T = NB * S, NT = 512;
constexpr int DIN = 3592, NP = 3584;
constexpr float LOG2E = 1.4426950408889634f;
constexpr float EPS = 1e-6f;

constexpr size_t OFF_BAR = 0;
constexpr size_t OFF_CTR = 16384;
constexpr size_t OFF_WTIN = 32768;
constexpr size_t OFF_WTOUT = OFF_WTIN + (size_t)NL * NP * DM * 2;
constexpr size_t OFF_WTPOOL = OFF_WTOUT + (size_t)NL * DM * DM * 2;
constexpr size_t OFF_WTFF = OFF_WTPOOL + (size_t)NL * 4 * 64 * 64 * 2;
constexpr size_t OFF_XB = OFF_WTFF + (size_t)NL * 16 * DM * 2;
constexpr size_t OFF_SSQ = OFF_XB + (size_t)T * DM * 2;
constexpr size_t OFF_QF = OFF_SSQ + (size_t)T * 16 * 4;
constexpr size_t OFF_KF = OFF_QF + (size_t)T * 512 * 2;
constexpr size_t OFF_VTF = OFF_KF + (size_t)T * 512 * 2;
constexpr size_t OFF_PX = OFF_VTF + (size_t)T * 512 * 2;
constexpr size_t OFF_SQ = OFF_PX + (size_t)T * 256 * 2;
constexpr size_t OFF_SK = OFF_SQ + (size_t)T * 256 * 2;
constexpr size_t OFF_SVT = OFF_SK + (size_t)T * 256 * 2;
constexpr size_t OFF_LOGF = OFF_SVT + (size_t)T * 256 * 2;
constexpr size_t OFF_MIX = OFF_LOGF + (size_t)NB * 8 * S * 4;
constexpr size_t WS_NEED = OFF_MIX + (size_t)T * DM * 2;

struct Params {
    const float *x, *norm_g, *w_in, *b_f, *qg, *kg, *w_pool, *pool_scale, *w_out;
    float* out; char* ws; int use_cg; int pad;
};

constexpr int LDS_MISC = 131072;
constexpr int LDS_TOTAL = LDS_MISC + 2048;

DI unsigned pk2(float a, float b) { f32x2 v = {a, b}; bf2_t r = __builtin_convertvector(v, bf2_t); return __builtin_bit_cast(unsigned, r); }
DI float bf_lo(unsigned u) { return __uint_as_float(u << 16); }
DI float bf_hi(unsigned u) { return __uint_as_float(u & 0xffff0000u); }
DI float fexp2(float x) { return __builtin_amdgcn_exp2f(x); }
DI float flog2(float x) { return __builtin_amdgcn_logf(x); }
DI float silu_f(float v) { return v * __builtin_amdgcn_rcpf(1.f + fexp2(-v * LOG2E)); }
DI int swz(int row, int chunk) { return row * 128 + ((chunk ^ ((row >> 1) & 7)) << 4); }
DI bf16x8 pack8(float a0, float a1, float a2, float a3, float a4, float a5, float a6, float a7) {
    u32x4 u = {pk2(a0, a1), pk2(a2, a3), pk2(a4, a5), pk2(a6, a7)}; return __builtin_bit_cast(bf16x8, u);
}
DI void store4(short* p, float a, float b, float c, float d) { u32x2 o = {pk2(a, b), pk2(c, d)}; *(u32x2*)p = o; }
DI void store8(short* p, const f32x4& a, const f32x4& b) { u32x4 o = {pk2(a[0], a[1]), pk2(a[2], a[3]), pk2(b[0], b[1]), pk2(b[2], b[3])}; *(u32x4*)p = o; }
#define XB_TMO      128
#define XB_XCNT(j)  (256  + 64 * (j))
#define XB_XSUB(j)  (1280 + 64 * (j))
#define XB_XGEN(j)  (2304 + 64 * (j))
#define XB_TOP      3328
#define XB_TOPGEN   3392
#define XCD_BAR_WORDS 3456
#define XB_SPIN_CAP (1u << 22)
DI unsigned xb_ld(unsigned* p)              { return __hip_atomic_load(p, __ATOMIC_RELAXED, __HIP_MEMORY_SCOPE_AGENT); }
DI unsigned xb_add(unsigned* p, unsigned v) { return __hip_atomic_fetch_add(p, v, __ATOMIC_RELAXED, __HIP_MEMORY_SCOPE_AGENT); }
DI unsigned xb_xcc_id() { return (unsigned)__builtin_amdgcn_readfirstlane((int)(__builtin_amdgcn_s_getreg((3 << 11) | 20) & 0xFu)); }
#define XB_SPIN(cond, bar) do { unsigned _sp = 0; while (cond) { __builtin_amdgcn_s_sleep(1); \
    if ((++_sp & 255u) == 0u) { if (xb_ld(&(bar)[XB_TMO])) break; if (_sp > XB_SPIN_CAP) { atomicAdd(&(bar)[XB_TMO], 1u); break; } } } } while (0)
struct XcdBarrier { unsigned* bar; unsigned x; volatile LAS unsigned* st; };
DI XcdBarrier xcd_barrier_post(unsigned* bar, volatile LAS unsigned* st) {
    XcdBarrier b; b.bar = bar; b.x = xb_xcc_id(); b.st = st;
    if (threadIdx.x == 0) (void)xb_add(&bar[XB_XCNT(b.x)], 1u);
    return b;
}
DI void xcd_barrier_complete(unsigned* bar, unsigned x, unsigned& nloc, unsigned& nx) {
    const unsigned G = gridDim.x * gridDim.y * gridDim.z;
    unsigned sum, cnt, mine, sp = 0u;
    for (;;) {
        sum = 0u; cnt = 0u; mine = 0u;
#pragma unroll
        for (unsigned j = 0; j < 16; ++j) { const unsigned c = xb_ld(&bar[XB_XCNT(j)]); sum += c; cnt += (c > 0u) ? 1u : 0u; mine = (j == x) ? c : mine; }
        if (sum == G) break;
        __builtin_amdgcn_s_sleep(1);
        if ((++sp & 255u) == 0u) { if (xb_ld(&bar[XB_TMO])) break; if (sp > XB_SPIN_CAP) { atomicAdd(&bar[XB_TMO], 1u); break; } }
    }
    nloc = mine > 0u ? mine : 1u; nx = cnt > 0u ? cnt : 1u;
}
DI void xcd_barrier(const XcdBarrier& b) {
    asm volatile("s_waitcnt vmcnt(0)" ::: "memory");
    __syncthreads();
    if (threadIdx.x == 0) {
        unsigned* bar = b.bar;
        __builtin_amdgcn_s_waitcnt(0);
        unsigned nloc = b.st[0], nx = b.st[1];
        if (nloc == 0u) { xcd_barrier_complete(bar, b.x, nloc, nx); b.st[0] = nloc; b.st[1] = nx; }
        const unsigned old = xb_add(&bar[XB_XSUB(b.x)], 1u);
        const unsigned gen = old / nloc;
        if (old + 1u == (gen + 1u) * nloc) {
            __builtin_amdgcn_fence(__ATOMIC_RELEASE, "agent");
            asm volatile("s_waitcnt vmcnt(0)" ::: "memory");
            const unsigned og = xb_add(&bar[XB_TOP], 1u);
            const unsigned tg = og / nx;
            if (og + 1u == (tg + 1u) * nx) xb_add(&bar[XB_TOPGEN], 1u);
            else XB_SPIN(xb_ld(&bar[XB_TOPGEN]) == tg, bar);
            __builtin_amdgcn_fence(__ATOMIC_ACQUIRE, "agent");
            xb_add(&bar[XB_XGEN(b.x)], 1u);
            asm volatile("s_waitcnt vmcnt(0)" ::: "memory");
        } else {
            XB_SPIN(xb_ld(&bar[XB_XGEN(b.x)]) == gen, bar);
            __builtin_amdgcn_fence(__ATOMIC_ACQUIRE, "agent");
            asm volatile("s_waitcnt vmcnt(0)" ::: "memory");
        }
    }
    __syncthreads();
}

namespace pg8 {
#define PG8_LAS __attribute__((address_space(3)))
typedef unsigned short bf16_t;
typedef short bf16x8 __attribute__((ext_vector_type(8)));
typedef float f32x4 __attribute__((ext_vector_type(4)));
typedef unsigned u32x4 __attribute__((ext_vector_type(4)));
constexpr int BM = 256, BK = 64, HALF = 128, HTB = HALF * BK * 2  , STAGE_BYTES = 8 * HTB, NXCD = 8, WGM = 8;

__host__ __device__ __forceinline__ int lds_byte(int r, int c) { const int st = (r >> 4) * 2 + (c >> 5), rr = r & 15, cc = c & 31, ob = rr * 64 + cc * 2; return st * 1024 + (ob ^ (((ob >> 9) & 1) << 5)); }
__host__ __device__ __forceinline__ void stage_rc(int b, int& R, int& C) { const int st = b / 1024, sb = b % 1024, swz = sb ^ (((sb >> 9) & 1) << 5); R = (st >> 1) * 16 + swz / 64; C = (st & 1) * 32 + (swz % 64) / 2; }
__host__ __device__ __forceinline__ int perm32(int rho) { const int n = rho >> 4, i = rho & 15; return 8 * (i >> 2) + 4 * n + (i & 3); }

struct Unit { int pm, pn; };
struct Gemm { const bf16_t* A; const bf16_t* Bt; int M, N, K; };

struct StaticOrder {
    int nM, nN, nwg, G, c;
    __host__ __device__ void init(int M, int N, int G_, int c_) { nM = M / BM; nN = N / BM; nwg = nM * nN; G = G_; c = c_; }
    __host__ __device__ bool next(int i, Unit& u) const {
        const long L = (long)i * G + c; if (L >= nwg) return false;
        int wgid = (int)L; { const int q = nwg / NXCD, r = nwg % NXCD, xcd = wgid % NXCD, off = wgid / NXCD; wgid = (xcd < r ? xcd * (q + 1) : r * (q + 1) + (xcd - r) * q) + off; }
        const int nig = WGM * nN, gid = wgid / nig, fm = gid * WGM, gsz = (nM - fm) < WGM ? (nM - fm) : WGM;
        u.pm = fm + ((wgid % nig) % gsz); u.pn = (wgid % nig) / gsz; return true;
    }
    __device__ __forceinline__ void a_ready(const Unit&) const {}
    __device__ __forceinline__ void done(const Unit&) const {}
};
template <class Epi, class Sched, bool ALIGN_EPI = false, bool SP2 = false>
__device__ __forceinline__ void gemm_phase(PG8_LAS unsigned char* lds, const Gemm g, const Sched& S, const Epi& E) {
    int tid = threadIdx.x; asm volatile("" : "+v"(tid));
    const int wid = __builtin_amdgcn_readfirstlane(tid >> 6), lane = tid & 63, wr = wid >> 2, wc = wid & 3, fr = lane & 15, fq = lane >> 4;
    const int K = g.K, nt = K / BK;
    unsigned voffA[2], voffB[2];
#pragma unroll
    for (int i = 0; i < 2; ++i) { int R, C; stage_rc(tid * 16 + i * 8192, R, C); const int Rb = Epi::PERM ? ((R & ~31) + perm32(R & 31)) : R;
        voffA[i] = (unsigned)(R * K + C) * 2u; voffB[i] = (unsigned)(Rb * K + C) * 2u; }
    const size_t kstep = (size_t)(BK * 2);
    const size_t hstep = (size_t)HALF * K * 2;
    const size_t tstep = 2 * hstep;
    const unsigned ldsw = (unsigned)wid * 1024u;
    const int aoff = lds_byte(wr * 64 + fr, fq * 8), boff = lds_byte(wc * 32 + fr, fq * 8);
#define PG8_SA(b, h) (((b) * 2 + (h)) * HTB)
#define PG8_SB(b, h) ((4 + (b) * 2 + (h)) * HTB)
#define PG8_STAGE(bufoff, gbase, voff) do { _Pragma("unroll") for (int _i = 0; _i < 2; ++_i) \
        __builtin_amdgcn_global_load_lds((const unsigned*)((const char*)(gbase) + (voff)[_i]), (PG8_LAS unsigned*)(lds + (bufoff) + ldsw + _i * 8192), 16, 0, 0); } while (0)
#define PG8_LDA(dst, b, h) do { _Pragma("unroll") for (int m = 0; m < 4; ++m) _Pragma("unroll") for (int k = 0; k < 2; ++k) dst[m][k] = *(const PG8_LAS bf16x8*)(lds + PG8_SA(b, h) + aoff + m * 2048 + k * 1024); } while (0)
#define PG8_LDB(dst, b, h) do { _Pragma("unroll") for (int n = 0; n < 2; ++n) _Pragma("unroll") for (int k = 0; k < 2; ++k) dst[n][k] = *(const PG8_LAS bf16x8*)(lds + PG8_SB(b, h) + boff + n * 2048 + k * 1024); } while (0)
#define PG8_MMA(ai, bj, At, Bt) do { __builtin_amdgcn_s_setprio(1); _Pragma("unroll") for (int m = 0; m < 4; ++m) _Pragma("unroll") for (int n = 0; n < 2; ++n) _Pragma("unroll") for (int k = 0; k < 2; ++k) \
        acc[ai][bj][m][n] = __builtin_amdgcn_mfma_f32_16x16x32_bf16(Bt[n][k], At[m][k], acc[ai][bj][m][n], 0, 0, 0); __builtin_amdgcn_s_setprio(0); } while (0)
#define PG8_WAIT_V(n) asm volatile("s_waitcnt vmcnt(" #n ")" ::: "memory")
#define PG8_WAIT_L(n) asm volatile("s_waitcnt lgkmcnt(" #n ")" ::: "memory")
#define PG8_BAR __builtin_amdgcn_s_barrier()
#define PG8_SCHED __builtin_amdgcn_sched_barrier(0)
    Unit cur, nxt; int ui = 0;
    if (!S.next(0, cur)) return;
    f32x4 acc[2][2][4][2];
#pragma unroll
    for (int a = 0; a < 2; ++a)
#pragma unroll
        for (int b = 0; b < 2; ++b)
#pragma unroll
            for (int m = 0; m < 4; ++m)
#pragma unroll
                for (int n = 0; n < 2; ++n) acc[a][b][m][n] = (f32x4){0.f, 0.f, 0.f, 0.f};
    bf16x8 At[4][2], B0[2][2], B1[2][2];
    const char* cA = (const char*)g.A + (size_t)cur.pm * tstep; const char* cB = (const char*)g.Bt + (size_t)cur.pn * tstep;
    S.a_ready(cur);
    if constexpr (SP2) {
        PG8_STAGE(PG8_SB(0, 0), cB, voffB); PG8_STAGE(PG8_SB(0, 1), cB + hstep, voffB); PG8_STAGE(PG8_SA(0, 0), cA, voffA); PG8_STAGE(PG8_SA(0, 1), cA + hstep, voffA);
        if (wr == 1) PG8_BAR;
        PG8_WAIT_V(2); PG8_BAR;
        PG8_STAGE(PG8_SB(1, 0), cB + kstep, voffB); PG8_STAGE(PG8_SA(1, 0), cA + kstep, voffA); PG8_STAGE(PG8_SB(1, 1), cB + hstep + kstep, voffB);
        PG8_WAIT_V(6); PG8_BAR;
    } else {
        PG8_STAGE(PG8_SB(0, 0), cB, voffB); PG8_STAGE(PG8_SA(0, 0), cA, voffA); PG8_STAGE(PG8_SB(0, 1), cB + hstep, voffB); PG8_STAGE(PG8_SA(0, 1), cA + hstep, voffA);
        if (wr == 1) PG8_BAR;
        PG8_WAIT_V(4); PG8_BAR;
        PG8_STAGE(PG8_SB(1, 0), cB + kstep, voffB); PG8_STAGE(PG8_SA(1, 0), cA + kstep, voffA); PG8_STAGE(PG8_SB(1, 1), cB + hstep + kstep, voffB);
        PG8_WAIT_V(6); PG8_BAR;
    }
    for (;;) {
        const bool has_next = S.next(ui + 1, nxt);
        const char* nA = has_next ? (const char*)g.A + (size_t)nxt.pm * tstep : cA; const char* nB = has_next ? (const char*)g.Bt + (size_t)nxt.pn * tstep : cB;
        for (int t = 0; t < nt; t += 2) {
            const bool last = (t == nt - 2);
            const char* a1 = cA + (size_t)(t + 1) * kstep;
            const char* a2 = last ? nA : cA + (size_t)(t + 2) * kstep; const char* b2 = last ? nB : cB + (size_t)(t + 2) * kstep;
            const char* a3 = a2 + kstep; const char* b3 = b2 + kstep;
            if (last && has_next) S.a_ready(nxt);
            if constexpr (SP2) {
            PG8_LDB(B0, 0, 0); PG8_LDB(B1, 0, 1); PG8_SCHED; PG8_LDA(At, 0, 0); PG8_STAGE(PG8_SA(1, 1), a1 + hstep, voffA);
            PG8_WAIT_V(8); PG8_WAIT_L(0); PG8_BAR; PG8_MMA(0, 0, At, B0); PG8_MMA(0, 1, At, B1); PG8_BAR; PG8_SCHED;
            PG8_LDA(At, 0, 1); PG8_STAGE(PG8_SB(0, 0), b2, voffB); PG8_STAGE(PG8_SB(0, 1), b2 + hstep, voffB); PG8_STAGE(PG8_SA(0, 0), a2, voffA);
            PG8_WAIT_V(8); PG8_WAIT_L(0); PG8_BAR; PG8_MMA(1, 0, At, B0); PG8_MMA(1, 1, At, B1); PG8_BAR; PG8_SCHED;
            PG8_LDB(B0, 1, 0); PG8_LDB(B1, 1, 1); PG8_SCHED; PG8_LDA(At, 1, 0); PG8_STAGE(PG8_SA(0, 1), a2 + hstep, voffA);
            PG8_WAIT_V(8); PG8_WAIT_L(0); PG8_BAR; PG8_MMA(0, 0, At, B0); PG8_MMA(0, 1, At, B1); PG8_BAR; PG8_SCHED;
            PG8_LDA(At, 1, 1); PG8_STAGE(PG8_SB(1, 0), b3, voffB); PG8_STAGE(PG8_SB(1, 1), b3 + hstep, voffB); PG8_STAGE(PG8_SA(1, 0), a3, voffA);
            PG8_WAIT_V(8); PG8_WAIT_L(0); PG8_BAR; PG8_MMA(1, 0, At, B0); PG8_MMA(1, 1, At, B1); PG8_BAR; PG8_SCHED;
            } else {
            PG8_LDB(B0, 0, 0); PG8_SCHED; PG8_LDA(At, 0, 0); PG8_STAGE(PG8_SA(1, 1), a1 + hstep, voffA);
            PG8_WAIT_L(8); PG8_BAR; PG8_WAIT_L(0); PG8_MMA(0, 0, At, B0); PG8_BAR; PG8_SCHED;
            PG8_LDB(B1, 0, 1); PG8_STAGE(PG8_SB(0, 0), b2, voffB);
            PG8_BAR; PG8_WAIT_L(0); PG8_MMA(0, 1, At, B1); PG8_BAR;
            PG8_LDA(At, 0, 1); PG8_STAGE(PG8_SA(0, 0), a2, voffA);
            PG8_BAR; PG8_WAIT_L(0); PG8_MMA(1, 0, At, B0); PG8_BAR; PG8_SCHED;
            PG8_STAGE(PG8_SB(0, 1), b2 + hstep, voffB);
            PG8_WAIT_V(6); PG8_BAR; PG8_MMA(1, 1, At, B1); PG8_BAR;
            PG8_LDB(B0, 1, 0); PG8_SCHED; PG8_LDA(At, 1, 0); PG8_STAGE(PG8_SA(0, 1), a2 + hstep, voffA);
            PG8_WAIT_L(8); PG8_BAR; PG8_WAIT_L(0); PG8_MMA(0, 0, At, B0); PG8_BAR; PG8_SCHED;
            PG8_LDB(B1, 1, 1); PG8_STAGE(PG8_SB(1, 0), b3, voffB);
            PG8_BAR; PG8_WAIT_L(0); PG8_MMA(0, 1, At, B1); PG8_BAR;
            PG8_LDA(At, 1, 1); PG8_STAGE(PG8_SA(1, 0), a3, voffA);
            PG8_BAR; PG8_WAIT_L(0); PG8_MMA(1, 0, At, B0); PG8_BAR; PG8_SCHED;
            PG8_STAGE(PG8_SB(1, 1), b3 + hstep, voffB);
            PG8_WAIT_V(6); PG8_BAR; PG8_MMA(1, 1, At, B1); PG8_BAR;
            }
        }
        if constexpr (ALIGN_EPI) { if (wr == 0) PG8_BAR; }
        if constexpr (!Epi::AFTER_DRAIN) { E(acc, cur, wr, wc, fr, fq); S.done(cur); }
        if (!has_next) break;
#pragma unroll
        for (int a = 0; a < 2; ++a)
#pragma unroll
            for (int b = 0; b < 2; ++b)
#pragma unroll
                for (int m = 0; m < 4; ++m)
#pragma unroll
                    for (int n = 0; n < 2; ++n) acc[a][b][m][n] = (f32x4){0.f, 0.f, 0.f, 0.f};
        cur = nxt; cA = nA; cB = nB; ++ui;
        if constexpr (ALIGN_EPI) { if (wr == 1) PG8_BAR; }
    }
    PG8_WAIT_V(0);
    if constexpr (!ALIGN_EPI) { if (wr == 0) PG8_BAR; }
    PG8_BAR;
    if constexpr (Epi::AFTER_DRAIN) { E.fused(acc, cur, wr, wc, fr, fq, lds, wid, lane); S.done(cur); }
#undef PG8_SA
#undef PG8_SB
#undef PG8_STAGE
#undef PG8_LDA
#undef PG8_LDB
#undef PG8_MMA
#undef PG8_WAIT_V
#undef PG8_WAIT_L
#undef PG8_BAR
#undef PG8_SCHED
}
}

DI unsigned* gate_ptr(const char* ws, int l, int k) { return (unsigned*)(ws + OFF_CTR) + 1024 + (l * 2 + k) * 320; }
DI void gate_arrive(unsigned* g, int tid, unsigned xcc, unsigned nloc) {
    asm volatile("s_waitcnt vmcnt(0)" ::: "memory");
    __syncthreads();
    if (tid == 0) {
        const unsigned old = xb_add(g + 16 * (xcc + 1), 1u);
        if (old + 1u == nloc) {
            __builtin_amdgcn_fence(__ATOMIC_RELEASE, "agent");
            asm volatile("s_waitcnt vmcnt(0)" ::: "memory");
            (void)xb_add(g, nloc);
        }
    }
}
DI void gate_wait(unsigned* g, unsigned target, int tid) {
    if (tid == 0) {
        unsigned sp = 0;
        while (xb_ld(g) < target) { __builtin_amdgcn_s_sleep(2); if (++sp > (1u << 24)) break; }
        __builtin_amdgcn_fence(__ATOMIC_ACQUIRE, "agent");
        asm volatile("s_waitcnt vmcnt(0)" ::: "memory");
    }
    __syncthreads();
}

DI int inproj_srccol(int np) {
    const int pn = np >> 8, c = np & 255, bj = c >> 7, wc = (c & 127) >> 5, j = c & 31;
    const int nlog = pn * 256 + 64 * wc + 32 * bj + j;
    return nlog < 2048 ? nlog : nlog + 8;
}
template <int MODE>
DI void transpose_tile(const float* src, int lds_, int k0, const float* gk, const float* gn, short* dst, int ldd, int n0, float* tile, int tid) {
    __syncthreads();
    {
        const int n4 = (tid & 15) * 4, kq = tid >> 4;
        const int col = (MODE == 0) ? inproj_srccol(n0 + n4) : (n0 + n4);
        f32x4 gnv = {1.f, 1.f, 1.f, 1.f};
        if (gn) gnv = *(const f32x4*)(gn + n0 + n4);
#pragma unroll
        for (int i = 0; i < 2; ++i) {
            const int k = i * 32 + kq;
            f32x4 v = *(const f32x4*)(src + (size_t)(k0 + k) * lds_ + col);
            const float g = gk ? gk[k0 + k] : 1.f;
            v = v * gnv * g;
            tile[k * 65 + n4] = v[0]; tile[k * 65 + n4 + 1] = v[1]; tile[k * 65 + n4 + 2] = v[2]; tile[k * 65 + n4 + 3] = v[3];
        }
    }
    __syncthreads();
    {
        const int n = tid >> 3, k8 = (tid & 7) * 8;
        u32x4 o;
#pragma unroll
        for (int q = 0; q < 4; ++q) o[q] = pk2(tile[(k8 + 2 * q) * 65 + n], tile[(k8 + 2 * q + 1) * 65 + n]);
        *(u32x4*)(dst + (size_t)(n0 + n) * ldd + k0 + k8) = o;
    }
}

DI void convert_layer(const Params& p, int l, char* lds, int tid, int vb, int nb) {
    float* tile = (float*)lds;
    short* wtin = (short*)(p.ws + OFF_WTIN) + (size_t)l * NP * DM; short* wtout = (short*)(p.ws + OFF_WTOUT) + (size_t)l * DM * DM;
    short* wtpool = (short*)(p.ws + OFF_WTPOOL) + (size_t)l * 4 * 4096; short* wtff = (short*)(p.ws + OFF_WTFF) + (size_t)l * 16 * DM;
    for (int e = vb * NT + tid; e < 16 * DM; e += nb * NT) {
        const int f = e >> 10, k = e & (DM - 1);
        const float v = (f < 8) ? p.w_in[((size_t)l * DM + k) * DIN + 2048 + f] * p.norm_g[l * DM + k] : 0.f;
        wtff[e] = (short)(pk2(v, 0.f) & 0xffffu);
    }
    if (vb == 0 && tid < 64) {
        float gq = fabsf(p.qg[l * 64 + tid]), gk = fabsf(p.kg[l * 64 + tid]);
#pragma unroll
        for (int d = 32; d >= 1; d >>= 1) { gq = fmaxf(gq, __shfl_xor(gq, d)); gk = fmaxf(gk, __shfl_xor(gk, d)); }
        if (tid == 0) ((float*)(p.ws + OFF_CTR))[3968 + l] = 8.f * gq * gk * LOG2E * 1.02f + 0.25f;
    }
    constexpr int U_IN = 16 * 56, U_OUT = 16 * 16, U_POOL = 4;
    for (int u = vb; u < U_IN + U_OUT + U_POOL; u += nb) {
        if (u < U_IN) {
            const int ntile = u / 16, kt = u % 16;
            transpose_tile<0>(p.w_in + (size_t)l * DM * DIN, DIN, kt * 64, p.norm_g + l * DM, nullptr, wtin, DM, ntile * 64, tile, tid);
        } else if (u < U_IN + U_OUT) {
            const int v = u - U_IN; const int ntile = v / 16, kt = v % 16;
            transpose_tile<1>(p.w_out + (size_t)l * DM * DM, DM, kt * 64, nullptr, nullptr, wtout, DM, ntile * 64, tile, tid);
        } else {
            const int g = u - U_IN - U_OUT;
            transpose_tile<1>(p.w_pool + (size_t)(l * 4 + g) * 4096, 64, 0, nullptr, p.pool_scale + l * 256 + g * 64, wtpool + (size_t)g * 4096, 64, 0, tile, tid);
        }
    }
    __syncthreads();
}

DI void phase_prologue(const Params& p, char* lds, int tid) {
    if (blockIdx.x == 0 && tid < 16) ((unsigned*)(p.ws + OFF_CTR))[tid] = 0u;
    convert_layer(p, 0, lds, tid, (int)blockIdx.x, (int)gridDim.x);
    short* xb = (short*)(p.ws + OFF_XB); float* ssq = (float*)(p.ws + OFF_SSQ);
    const int lane = tid & 63, w = tid >> 6;
    for (int row = blockIdx.x * 8 + w; row < T; row += gridDim.x * 8) {
        const float* xr = p.x + (size_t)row * DM;
        float ss = 0.f;
#pragma unroll
        for (int j = 0; j < 4; ++j) {
            const f32x4 v = *(const f32x4*)(xr + j * 256 + lane * 4);
            ss += v[0] * v[0] + v[1] * v[1] + v[2] * v[2] + v[3] * v[3];
            u32x2 o = {pk2(v[0], v[1]), pk2(v[2], v[3])};
            *(u32x2*)(xb + (size_t)row * DM + j * 256 + lane * 4) = o;
        }
#pragma unroll
        for (int d = 32; d >= 1; d >>= 1) ss += __shfl_xor(ss, d);
        if (lane < 16) ssq[(size_t)row * 16 + lane] = (lane == 0) ? ss : 0.f;
    }
}

typedef float pf32x4 __attribute__((ext_vector_type(4)));
DI float row_rstd(const float* ssq, int row, int fq) {
    const f32x4 v = *(const f32x4*)(ssq + (size_t)row * 16 + 4 * fq);
    float s = (v[0] + v[1]) + (v[2] + v[3]);
    s += __shfl_xor(s, 16); s += __shfl_xor(s, 32);
    return __builtin_amdgcn_rsqf(s * (1.f / 1024.f) + EPS);
}
struct EpiIn {
    static constexpr bool PERM = true, AFTER_DRAIN = false;
    char* ws; const float* qg; const float* kg;
    DI void operator()(const pg8::f32x4 (&acc)[2][2][4][2], const pg8::Unit& u, int wr, int wc, int fr, int fq) const {
        asm volatile("" : "+v"(fr), "+v"(fq));
        const int pn = u.pn;
        const float* ssq = (const float*)(ws + OFF_SSQ);
        float rstdv[2][4];
        {
            f32x4 sv[2][4];
#pragma unroll
            for (int ai = 0; ai < 2; ++ai)
#pragma unroll
                for (int m = 0; m < 4; ++m) sv[ai][m] = *(const f32x4*)(ssq + (size_t)(u.pm * 256 + ai * 128 + wr * 64 + m * 16 + fr) * 16 + 4 * fq);
            PIN8(sv);
#pragma unroll
            for (int ai = 0; ai < 2; ++ai)
#pragma unroll
                for (int m = 0; m < 4; ++m) {
                    float sx = (sv[ai][m][0] + sv[ai][m][1]) + (sv[ai][m][2] + sv[ai][m][3]);
                    sx += __shfl_xor(sx, 16); sx += __shfl_xor(sx, 32);
                    rstdv[ai][m] = __builtin_amdgcn_rsqf(sx * (1.f / 1024.f) + EPS);
                }
        }
#pragma unroll
        for (int ai = 0; ai < 2; ++ai)
#pragma unroll
            for (int m = 0; m < 4; ++m) {
                const int row = u.pm * 256 + ai * 128 + wr * 64 + m * 16 + fr;
                const float rstd = rstdv[ai][m];
                const int b = row >> 12, s = row & 4095;
                if (pn < 4) {
                    float ss = 0.f;
#pragma unroll
                    for (int bj = 0; bj < 2; ++bj)
#pragma unroll
                        for (int n = 0; n < 2; ++n)
#pragma unroll
                            for (int c = 0; c < 4; ++c) { const float v = acc[ai][bj][m][n][c]; ss += v * v; }
                    ss += __shfl_xor(ss, 16); ss += __shfl_xor(ss, 32);
                    ss *= rstd * rstd;
                    const float rn = __builtin_amdgcn_rsqf(ss * (1.f / 64.f) + EPS) * rstd * (pn < 2 ? 0.125f * LOG2E : 1.f);
                    const float* gv = (pn < 2) ? qg : kg;
                    short* dst = (short*)(ws + (pn < 2 ? OFF_QF : OFF_KF)) + ((size_t)(b * 8 + (pn & 1) * 4 + wc) * S + s) * 64;
#pragma unroll
                    for (int bj = 0; bj < 2; ++bj) {
                        const int d = 32 * bj + 8 * fq;
                        const f32x4 g0 = *(const f32x4*)(gv + d), g1 = *(const f32x4*)(gv + d + 4);
                        const f32x4 v0 = acc[ai][bj][m][0] * (g0 * rn), v1 = acc[ai][bj][m][1] * (g1 * rn);
                        store8(dst + d, v0, v1);
                    }
                } else if (pn == 4 || pn == 5 || pn == 12) {
                    short* base = (pn == 12) ? ((short*)(ws + OFF_SVT) + ((size_t)(b * 4 + wc) * 64) * S)
                                             : ((short*)(ws + OFF_VTF) + ((size_t)(b * 8 + (pn - 4) * 4 + wc) * 64) * S);
#pragma unroll
                    for (int bj = 0; bj < 2; ++bj)
#pragma unroll
                        for (int n = 0; n < 2; ++n)
#pragma unroll
                            for (int c = 0; c < 4; c += 2) {
                                const int d = 32 * bj + 8 * fq + 4 * n + c;
                                const unsigned pk = pk2(acc[ai][bj][m][n][c] * rstd, acc[ai][bj][m][n][c + 1] * rstd);
                                base[(size_t)d * S + s] = (short)(pk & 0xffffu);
                                base[(size_t)(d + 1) * S + s] = (short)(pk >> 16);
                            }
                } else {
                    short* dst; bool dosilu = false; float sc = rstd;
                    if (pn == 6 || pn == 7) { dst = (short*)(ws + OFF_MIX) + (size_t)row * DM + (pn - 6) * 256 + wc * 64; dosilu = true; }
                    else if (pn == 8) { dst = (short*)(ws + OFF_PX) + (size_t)row * 256 + wc * 64; }
                    else if (pn == 9) { dst = (short*)(ws + OFF_MIX) + (size_t)row * DM + 512 + wc * 64; dosilu = true; }
                    else if (pn == 10) { dst = (short*)(ws + OFF_SQ) + ((size_t)(b * 4 + wc) * S + s) * 64; sc = rstd * 0.125f * LOG2E; }
                    else if (pn == 11) { dst = (short*)(ws + OFF_SK) + ((size_t)(b * 4 + wc) * S + s) * 64; }
                    else { dst = (short*)(ws + OFF_MIX) + (size_t)row * DM + 768 + wc * 64; dosilu = true; }
#pragma unroll
                    for (int bj = 0; bj < 2; ++bj) {
                        f32x4 v0 = acc[ai][bj][m][0] * sc, v1 = acc[ai][bj][m][1] * sc;
                        if (dosilu) {
#pragma unroll
                            for (int c = 0; c < 4; ++c) { v0[c] = silu_f(v0[c]); v1[c] = silu_f(v1[c]); }
                        }
                        store8(dst + 32 * bj + 8 * fq, v0, v1);
                    }
                }
            }
    }
};
struct EpiOut {
    static constexpr bool PERM = true, AFTER_DRAIN = false;
    const float* res32; float* out; short* xb; float* ssq; int first; int last;
    DI void operator()(const pg8::f32x4 (&acc)[2][2][4][2], const pg8::Unit& u, int wr, int wc, int fr, int fq) const {
        asm volatile("" : "+v"(fr), "+v"(fq));
#pragma unroll
        for (int ai = 0; ai < 2; ++ai) {
            u32x4 rb[2][4];
            if (!first) {
#pragma unroll
                for (int m = 0; m < 4; ++m)
#pragma unroll
                    for (int bj = 0; bj < 2; ++bj)
                        rb[bj][m] = *(const u32x4*)(xb + (size_t)(u.pm * 256 + ai * 128 + wr * 64 + m * 16 + fr) * DM + u.pn * 256 + bj * 128 + wc * 32 + fq * 8);
                PIN8(rb);
            }
#pragma unroll
            for (int m = 0; m < 4; ++m) {
                const int row = u.pm * 256 + ai * 128 + wr * 64 + m * 16 + fr;
                float ss = 0.f;
#pragma unroll
                for (int bj = 0; bj < 2; ++bj) {
                    const size_t off = (size_t)row * DM + u.pn * 256 + bj * 128 + wc * 32 + fq * 8;
                    f32x4 r0, r1;
                    if (first) { r0 = *(const f32x4*)(res32 + off); r1 = *(const f32x4*)(res32 + off + 4); }
                    else {
                        const u32x4 rv = rb[bj][m];
                        r0 = (f32x4){bf_lo(rv[0]), bf_hi(rv[0]), bf_lo(rv[1]), bf_hi(rv[1])}; r1 = (f32x4){bf_lo(rv[2]), bf_hi(rv[2]), bf_lo(rv[3]), bf_hi(rv[3])};
                    }
                    const f32x4 o0 = r0 + acc[ai][bj][m][0], o1 = r1 + acc[ai][bj][m][1];
                    if (last) { *(f32x4*)(out + off) = o0; *(f32x4*)(out + off + 4) = o1; }
                    else {
                        ss += (o0[0] * o0[0] + o0[1] * o0[1]) + (o0[2] * o0[2] + o0[3] * o0[3]) + (o1[0] * o1[0] + o1[1] * o1[1]) + (o1[2] * o1[2] + o1[3] * o1[3]);
                        store8(xb + off, o0, o1);
                    }
                }
                if (!last) { ss += __shfl_xor(ss, 16); ss += __shfl_xor(ss, 32); if (fq == 0) ssq[(size_t)row * 16 + u.pn * 4 + wc] = ss; }
            }
        }
    }
};

DI void ff_job(const Params& p, int l, int tb, int tid) {
    const int lane = tid & 63, w = tid >> 6, fr = lane & 15, fq = lane >> 4;
    const int tok = tb * 128 + w * 16 + fr;
    const short* wff = (const short*)(p.ws + OFF_WTFF) + (size_t)l * 16 * DM + fr * DM + fq * 8;
    const short* xr = (const short*)(p.ws + OFF_XB) + (size_t)tok * DM + fq * 8;
    pg8::f32x4 acc = {0.f, 0.f, 0.f, 0.f};
#pragma unroll 16
    for (int ks = 0; ks < 32; ++ks) {
        const bf16x8 a = *(const bf16x8*)(wff + ks * 32), bq = *(const bf16x8*)(xr + ks * 32);
        acc = __builtin_amdgcn_mfma_f32_16x16x32_bf16(a, bq, acc, 0, 0, 0);
    }
    const float* sp = (const float*)(p.ws + OFF_SSQ) + (size_t)tok * 16;
    const f32x4 s0 = *(const f32x4*)sp, s1 = *(const f32x4*)(sp + 4), s2 = *(const f32x4*)(sp + 8), s3 = *(const f32x4*)(sp + 12);
    const float ssum = ((s0[0] + s0[1]) + (s0[2] + s0[3])) + ((s1[0] + s1[1]) + (s1[2] + s1[3])) + ((s2[0] + s2[1]) + (s2[2] + s2[3])) + ((s3[0] + s3[1]) + (s3[2] + s3[3]));
    const float rstd = __builtin_amdgcn_rsqf(ssum * (1.f / 1024.f) + EPS);
    if (fq < 2) {
        const int b = tok >> 12, s = tok & 4095;
        float* LOGF = (float*)(p.ws + OFF_LOGF);
#pragma unroll
        for (int i = 0; i < 4; ++i) {
            const int f = 4 * fq + i;
            const float v = acc[i] * rstd + p.b_f[l * 8 + f];
            LOGF[(size_t)(b * 8 + f) * S + s] = fminf(v, 0.f) - log1pf(expf(-fabsf(v)));
        }
    }
}

struct InSchedA {
    pg8::StaticOrder s;
    __device__ bool next(int i, pg8::Unit& u) const { if (!s.next(i, u)) return false; u.pn = (u.pn < 9) ? u.pn : u.pn + 1; return true; }
    DI void a_ready(const pg8::Unit&) const {}
    DI void done(const pg8::Unit&) const {}
};
struct InSchedB {
    pg8::StaticOrder s;
    __device__ bool next(int i, pg8::Unit& u) const { if (!s.next(i, u)) return false; u.pn = u.pn ? 13 : 9; return true; }
    DI void a_ready(const pg8::Unit&) const {}
    DI void done(const pg8::Unit&) const {}
};
DI void phase_inproj(const Params& p, int l, char* lds, int tid, unsigned xcc, unsigned nloc) {
    const int G = gridDim.x, c = (int)blockIdx.x;
    for (int tb = G - 1 - c; tb < 128; tb += G) ff_job(p, l, tb, tid);
    pg8::Gemm g{(const pg8::bf16_t*)(p.ws + OFF_XB), (const pg8::bf16_t*)(p.ws + OFF_WTIN) + (size_t)l * NP * DM, T, NP, DM};
    EpiIn E{p.ws, p.qg + l * 64, p.kg + l * 64};
    { InSchedA Sa; Sa.s.init(T, 12 * 256, G, c); pg8::gemm_phase<EpiIn, InSchedA, true, true>((PG8_LAS unsigned char*)lds, g, Sa, E); }
    gate_arrive(gate_ptr(p.ws, l, 0), tid, xcc, nloc);
    { InSchedB Sb; Sb.s.init(T, 2 * 256, G, c); pg8::gemm_phase<EpiIn, InSchedB, true, true>((PG8_LAS unsigned char*)lds, g, Sb, E); }
    gate_arrive(gate_ptr(p.ws, l, 1), tid, xcc, nloc);
}
DI void phase_outproj(const Params& p, int l, char* lds, int tid) {
    const int G = gridDim.x;
    pg8::Gemm g{(const pg8::bf16_t*)(p.ws + OFF_MIX), (const pg8::bf16_t*)(p.ws + OFF_WTOUT) + (size_t)l * DM * DM, T, DM, DM};
    pg8::StaticOrder So; So.init(T, DM, G, (int)blockIdx.x);
    EpiOut E{p.x, p.out, (short*)(p.ws + OFF_XB), (float*)(p.ws + OFF_SSQ), (l == 0) ? 1 : 0, (l + 1 == NL) ? 1 : 0};
    pg8::gemm_phase<EpiOut, pg8::StaticOrder, true, true>((PG8_LAS unsigned char*)lds, g, So, E);
}

constexpr int STG_BYTES = 16384, RING_OFF = 16384;
DI void glds16(const void* gsrc, unsigned lds_dst) {
    unsigned keep;
    asm volatile("s_mov_b32 %0, m0\n\ts_mov_b32 m0, %2\n\ts_nop 0\n\tglobal_load_lds_dwordx4 %1, off\n\ts_mov_b32 m0, %0" : "=&s"(keep) : "v"(gsrc), "s"(lds_dst) : "memory");
}
DI void kv_dma(const short* Kb, const short* Vtb, int j, char* stage, int tid) {
    const int w = tid >> 6, row = tid >> 3, ch = (tid & 7) ^ ((row >> 1) & 7);
    const unsigned dst = (unsigned)__builtin_amdgcn_readfirstlane((int)(unsigned)(size_t)(LAS char*)stage + w * 1024);
    glds16(Kb + (size_t)(64 * j + row) * 64 + ch * 8, dst);
    glds16(Vtb + (size_t)row * S + 64 * j + ch * 8, dst + 8192u);
}
DI void kv_wait_bar(int rem) {
    if (rem >= 2) asm volatile("s_waitcnt vmcnt(4)\n\ts_waitcnt lgkmcnt(0)\n\ts_barrier" ::: "memory");
    else if (rem == 1) asm volatile("s_waitcnt vmcnt(2)\n\ts_waitcnt lgkmcnt(0)\n\ts_barrier" ::: "memory");
    else asm volatile("s_waitcnt vmcnt(0)\n\ts_waitcnt lgkmcnt(0)\n\ts_barrier" ::: "memory");
}

DI void fox_qk(const char* kb, const float* cp, const bf16x8 (&qf)[4], float bt, int krow, int hi, f32x16 (&sacc)[2]) {
    bf16x8 kf[2][4];
#pragma unroll
    for (int sub = 0; sub < 2; ++sub)
#pragma unroll
        for (int kk = 0; kk < 4; ++kk) kf[sub][kk] = *(const bf16x8*)(kb + swz(32 * sub + krow, 2 * kk + hi));
    f32x4 cv[2][4];
#pragma unroll
    for (int sub = 0; sub < 2; ++sub)
#pragma unroll
        for (int q4 = 0; q4 < 4; ++q4) cv[sub][q4] = *(const f32x4*)(cp + 32 * sub + 4 * q4);
    PIN8(kf); PIN8(cv);
#pragma unroll
    for (int sub = 0; sub < 2; ++sub)
#pragma unroll
        for (int q4 = 0; q4 < 4; ++q4) {
            sacc[sub][4 * q4] = bt - cv[sub][q4][0]; sacc[sub][4 * q4 + 1] = bt - cv[sub][q4][1]; sacc[sub][4 * q4 + 2] = bt - cv[sub][q4][2]; sacc[sub][4 * q4 + 3] = bt - cv[sub][q4][3];
        }
    __builtin_amdgcn_s_setprio(1);
#pragma unroll
    for (int kk = 0; kk < 4; ++kk)
#pragma unroll
        for (int sub = 0; sub < 2; ++sub) sacc[sub] = MFMA32(kf[sub][kk], qf[kk], sacc[sub]);
    __builtin_amdgcn_s_setprio(0);
}
template <bool MASK>
DI void fox_sm(const f32x16 (&sacc)[2], int lim, float& lsum, bf16x8 (&pf)[2][2]) {
#pragma unroll
    for (int sub = 0; sub < 2; ++sub) {
        float pr[16];
#pragma unroll
        for (int i = 0; i < 16; ++i) {
            float pv = fexp2(sacc[sub][i]);
            if (MASK) { if (i + 32 * sub > lim) pv = 0.f; }
            pr[i] = pv;
        }
        pf[sub][0] = pack8(pr[0], pr[1], pr[2], pr[3], pr[4], pr[5], pr[6], pr[7]);
        pf[sub][1] = pack8(pr[8], pr[9], pr[10], pr[11], pr[12], pr[13], pr[14], pr[15]);
    }
}
DI void fox_pv(const char* vb, int r, int hi, const bf16x8 (&pf)[2][2], f32x16 (&oacc)[2], f32x16& lacc) {
    bf16x8 vf[2][4];
#pragma unroll
    for (int mi = 0; mi < 2; ++mi)
#pragma unroll
        for (int c = 0; c < 4; ++c) vf[mi][c] = *(const bf16x8*)(vb + swz(32 * mi + r, 4 * (c >> 1) + 2 * hi + (c & 1)));
    PIN8(vf);
    const u32x4 onesu = {0x3f803f80u, 0x3f803f80u, 0x3f803f80u, 0x3f803f80u};
    const bf16x8 ones = __builtin_bit_cast(bf16x8, onesu);
    __builtin_amdgcn_s_setprio(1);
#pragma unroll
    for (int c = 0; c < 4; ++c) {
#pragma unroll
        for (int mi = 0; mi < 2; ++mi) oacc[mi] = MFMA32(vf[mi][c], pf[c >> 1][c & 1], oacc[mi]);
        lacc = MFMA32(ones, pf[c >> 1][c & 1], lacc);
    }
    __builtin_amdgcn_s_setprio(0);
}
DI void fox_unit(const Params& p, int l, int bh, int qb, char* lds, int tid) {
    const int lane = tid & 63, w = tid >> 6, r = lane & 31, hi = lane >> 5;
    float* cs = (float*)lds; char* ring = lds + RING_OFF; float* misc = (float*)(lds + LDS_MISC);
    const short* Kb = (const short*)(p.ws + OFF_KF) + (size_t)bh * S * 64;
    const short* Vtb = (const short*)(p.ws + OFF_VTF) + (size_t)bh * 64 * S;
    const int kmax = (qb + 1) * 256, jmax = 4 * qb + 3;
    kv_dma(Kb, Vtb, jmax, ring, tid);
    const float M2 = ((const float*)(p.ws + OFF_CTR))[3968 + l];
    const int qrow = qb * 256 + w * 32 + r;
    bf16x8 qf[4];
    {
        const short* qp = (const short*)(p.ws + OFF_QF) + ((size_t)bh * S + qrow) * 64 + hi * 8;
#pragma unroll
        for (int kk = 0; kk < 4; ++kk) qf[kk] = *(const bf16x8*)(qp + kk * 16);
    }
    {
        const float* lf = (const float*)(p.ws + OFF_LOGF) + (size_t)bh * S + tid * 8;
        float v[8];
        if (tid * 8 < kmax) {
#pragma unroll
            for (int q = 0; q < 2; ++q) { const f32x4 t4 = *(const f32x4*)(lf + 4 * q); v[4 * q] = t4[0]; v[4 * q + 1] = t4[1]; v[4 * q + 2] = t4[2]; v[4 * q + 3] = t4[3]; }
        } else {
#pragma unroll
            for (int q = 0; q < 8; ++q) v[q] = 0.f;
        }
#pragma unroll
        for (int q = 1; q < 8; ++q) v[q] += v[q - 1];
        const float tot = v[7];
        float sc = tot;
#pragma unroll
        for (int d = 1; d < 64; d <<= 1) { const float t2 = __shfl_up(sc, d); if (lane >= d) sc += t2; }
        if (lane == 63) misc[w] = sc;
        __syncthreads();
        float off = sc - tot;
        for (int j = 0; j < w; ++j) off += misc[j];
#pragma unroll
        for (int q = 0; q < 8; ++q) cs[tid * 8 + q] = (off + v[q]) * LOG2E;
    }
    __syncthreads();
    int jlo = 0;
#if FOX_SKIP
    {
        const float cq = cs[qb * 256];
        const bool c = (lane <= jmax) && (cq - cs[64 * lane + 63] < -(152.f + 2.f * M2));
        const unsigned long long mask = __ballot(c);
        jlo = mask ? (64 - __builtin_clzll(mask)) : 0;
        if (jlo > jmax) jlo = jmax;
    }
#endif
    int jloww = jlo;
#if FOX_SKIP
    {
        const float cqw = cs[qb * 256 + w * 32];
        const bool c2 = (lane <= jmax) && (cqw - cs[64 * lane + 63] < -(152.f + 2.f * M2));
        const unsigned long long mask2 = __ballot(c2);
        jloww = mask2 ? (64 - __builtin_clzll(mask2)) : 0;
        const int jdiag = (qb * 256 + w * 32) >> 6;
        if (jloww > jdiag) jloww = jdiag;
        if (jloww < jlo) jloww = jlo;
    }
#endif
    float bt = cs[qrow] - M2;
    asm volatile("" : "+v"(qf[0]), "+v"(qf[1]), "+v"(qf[2]), "+v"(qf[3]), "+v"(bt));
    asm volatile("s_waitcnt vmcnt(0)" ::: "memory");
#pragma unroll
    for (int t = 1; t < 4; ++t) if (jmax - t >= jlo) kv_dma(Kb, Vtb, jmax - t, ring + t * STG_BYTES, tid);
    f32x16 oacc[2];
#pragma unroll
    for (int mi = 0; mi < 2; ++mi)
#pragma unroll
        for (int i = 0; i < 16; ++i) oacc[mi][i] = 0.f;
    float lsum = 0.f;
    f32x16 lacc;
#pragma unroll
    for (int i = 0; i < 16; ++i) lacc[i] = 0.f;
    const int qmin = qb * 256 + w * 32;
    const int krow = 16 * ((r >> 2) & 1) + 4 * (r >> 3) + (r & 3);
    const int ntl = jmax - jlo + 1;
    const int nch = (ntl + 1) >> 1;
    for (int c = 0; c < nch; ++c) {
        const int nnext = (2 * c + 3 < ntl) ? 2 : ((2 * c + 2 < ntl) ? 1 : 0);
        kv_wait_bar(nnext);
        {
            const int t0 = 2 * c + 4;
            if (t0 < ntl) kv_dma(Kb, Vtb, jmax - t0, ring + (t0 % 6) * STG_BYTES, tid);
            if (t0 + 1 < ntl) kv_dma(Kb, Vtb, jmax - t0 - 1, ring + ((t0 + 1) % 6) * STG_BYTES, tid);
        }
#pragma unroll
        for (int h2 = 0; h2 < 2; ++h2) {
            const int t = 2 * c + h2;
            const int key0 = 64 * (jmax - t);
            if (t < ntl && key0 <= qmin + 31 && (jmax - t) >= jloww) {
                const char* stg = ring + (t % 6) * STG_BYTES;
                f32x16 sc[2];
                fox_qk(stg, cs + key0 + 16 * hi, qf, bt, krow, hi, sc);
                bf16x8 pf[2][2];
                if (key0 + 63 > qmin) fox_sm<true>(sc, qrow - key0 - 16 * hi, lsum, pf); else fox_sm<false>(sc, 0, lsum, pf);
                fox_pv(stg + 8192, r, hi, pf, oacc, lacc);
            }
        }
    }
    lsum = lacc[0];
    const float inv = __builtin_amdgcn_rcpf(lsum);
    const int b = bh >> 3, h = bh & 7;
    short* mp = (short*)(p.ws + OFF_MIX) + (size_t)(b * S + qrow) * DM + h * 64;
#pragma unroll
    for (int mi = 0; mi < 2; ++mi)
#pragma unroll
        for (int g = 0; g < 4; ++g) {
            const int d = 32 * mi + 8 * g + 4 * hi;
            const u32x2 gv = *(const u32x2*)(mp + d);
            store4(mp + d, oacc[mi][4 * g] * inv * bf_lo(gv[0]), oacc[mi][4 * g + 1] * inv * bf_hi(gv[0]), oacc[mi][4 * g + 2] * inv * bf_lo(gv[1]), oacc[mi][4 * g + 3] * inv * bf_hi(gv[1]));
        }
}

template <bool MASK>
DI void sb_tile(const char* kb, const bf16x8 (&qf)[4], int krow, int r, int hi, int lim, f32x16 (&oacc)[2], float& Rc) {
    const char* vb = kb + 8192;
    bf16x8 kf[2][4];
#pragma unroll
    for (int sub = 0; sub < 2; ++sub)
#pragma unroll
        for (int kk = 0; kk < 4; ++kk) kf[sub][kk] = *(const bf16x8*)(kb + swz(32 * sub + krow, 2 * kk + hi));
    PIN8(kf);
    f32x16 z[2];
#pragma unroll
    for (int sub = 0; sub < 2; ++sub) {
#pragma unroll
        for (int i = 0; i < 16; ++i) z[sub][i] = 0.f;
#pragma unroll
        for (int kk = 0; kk < 4; ++kk) z[sub] = MFMA32(kf[sub][kk], qf[kk], z[sub]);
    }
    bf16x8 vf[2][4];
#pragma unroll
    for (int mi = 0; mi < 2; ++mi)
#pragma unroll
        for (int c = 0; c < 4; ++c) vf[mi][c] = *(const bf16x8*)(vb + swz(32 * mi + r, 4 * (c >> 1) + 2 * hi + (c & 1)));
    PIN8(vf);
    float Tt[2];
#pragma unroll
    for (int sub = 1; sub >= 0; --sub) {
        float run = 0.f;
#pragma unroll
        for (int i = 15; i >= 0; --i) {
            const float zz = z[sub][i];
            const float e = fexp2(-fabsf(zz));
            float sp = fmaxf(zz, 0.f) + flog2(1.f + e);
            float val = zz + (run - sp);
            if (MASK) { if (i + 32 * sub >= lim) { sp = 0.f; val = -INFINITY; } }
            z[sub][i] = val;
            run -= sp;
        }
        Tt[sub] = run;
    }
    const float T1p = __shfl_xor(Tt[1], 32), T0p = __shfl_xor(Tt[0], 32);
    const float sum1 = Tt[1] + T1p;
    float off[2];
    off[1] = Rc + (hi == 0 ? T1p : 0.f);
    off[0] = Rc + sum1 + (hi == 0 ? T0p : 0.f);
    Rc = Rc + sum1 + Tt[0] + T0p;
    bf16x8 pf[2][2];
#pragma unroll
    for (int sub = 0; sub < 2; ++sub) {
        float pr[16];
#pragma unroll
        for (int i = 0; i < 16; ++i) pr[i] = fexp2(z[sub][i] + off[sub]);
        pf[sub][0] = pack8(pr[0], pr[1], pr[2], pr[3], pr[4], pr[5], pr[6], pr[7]);
        pf[sub][1] = pack8(pr[8], pr[9], pr[10], pr[11], pr[12], pr[13], pr[14], pr[15]);
    }
#pragma unroll
    for (int c = 0; c < 4; ++c)
#pragma unroll
        for (int mi = 0; mi < 2; ++mi) oacc[mi] = MFMA32(vf[mi][c], pf[c >> 1][c & 1], oacc[mi]);
}

DI void sb_unit(const Params& p, int bh, int qb, char* lds, int tid) {
    const int lane = tid & 63, w = tid >> 6, r = lane & 31, hi = lane >> 5;
    char* ring = lds + RING_OFF; volatile int* flags = (volatile int*)(lds + LDS_MISC + 256);
    const short* Kb = (const short*)(p.ws + OFF_SK) + (size_t)bh * S * 64;
    const short* Vtb = (const short*)(p.ws + OFF_SVT) + (size_t)bh * 64 * S;
    const int jmax = 4 * qb + 3;
    const int qrow = qb * 256 + w * 32 + r;
    const int nwin = (jmax + 1 < 8) ? (jmax + 1) : 8;
#pragma unroll
    for (int t = 0; t < 8; ++t) if (t < nwin) kv_dma(Kb, Vtb, jmax - t, lds + t * STG_BYTES, tid);
    bf16x8 qf[4];
    {
        const short* qp = (const short*)(p.ws + OFF_SQ) + ((size_t)bh * S + qrow) * 64 + hi * 8;
#pragma unroll
        for (int kk = 0; kk < 4; ++kk) qf[kk] = *(const bf16x8*)(qp + kk * 16);
    }
    asm volatile("" : "+v"(qf[0]), "+v"(qf[1]), "+v"(qf[2]), "+v"(qf[3]));
    f32x16 oacc[2];
#pragma unroll
    for (int mi = 0; mi < 2; ++mi)
#pragma unroll
        for (int i = 0; i < 16; ++i) oacc[mi][i] = 0.f;
    float Rc = 0.f;
    const int qmin = qb * 256 + w * 32;
    const int krow = 16 * ((r >> 2) & 1) + 4 * (r >> 3) + (r & 3);
    asm volatile("s_waitcnt vmcnt(0)\n\ts_barrier" ::: "memory");
    const int tw = 3 - (w >> 1);
    bool wdone = false;
    for (int t = 0; t < nwin; ++t) {
        if (t >= tw && !wdone) {
            const int key0 = 64 * (jmax - t);
            const char* kb = lds + t * STG_BYTES;
            if (key0 + 63 >= qmin) sb_tile<true>(kb, qf, krow, r, hi, qrow - key0 - 16 * hi, oacc, Rc);
            else sb_tile<false>(kb, qf, krow, r, hi, 0, oacc, Rc);
            wdone = __all(Rc < -152.f);
        }
    }
    if (lane == 0) flags[16 + w] = wdone ? 1 : 0;
    __syncthreads();
    int ndw = 0;
#pragma unroll
    for (int q = 0; q < 8; ++q) ndw += flags[16 + q];
    const int jstart = jmax - 8;
    if (ndw < 8 && jstart >= 0) {
#pragma unroll
        for (int t = 0; t < 3; ++t) if (jstart - t >= 0) kv_dma(Kb, Vtb, jstart - t, ring + t * STG_BYTES, tid);
        int it = 0;
        for (int j = jstart; j >= 0; --j, ++it) {
            const int cur = it & 1;
            kv_wait_bar(j);
            if (j >= 3) kv_dma(Kb, Vtb, j - 3, ring + ((it + 3) & 3) * STG_BYTES, tid);
            if (it > 0) {
                int nd = 0;
#pragma unroll
                for (int q = 0; q < 8; ++q) nd += flags[(cur ^ 1) * 8 + q];
                if (nd == 8) break;
            }
            if (!wdone) {
                sb_tile<false>(ring + (it & 3) * STG_BYTES, qf, krow, r, hi, 0, oacc, Rc);
                wdone = __all(Rc < -152.f);
            }
            if (lane == 0) flags[cur * 8 + w] = wdone ? 1 : 0;
        }
        asm volatile("s_waitcnt vmcnt(0)" ::: "memory");
    }
    const int b = bh >> 2, h = bh & 3;
    short* mp = (short*)(p.ws + OFF_MIX) + (size_t)(b * S + qrow) * DM + 768 + h * 64;
#pragma unroll
    for (int mi = 0; mi < 2; ++mi)
#pragma unroll
        for (int g = 0; g < 4; ++g) {
            const int d = 32 * mi + 8 * g + 4 * hi;
            const u32x2 gv = *(const u32x2*)(mp + d);
            store4(mp + d, oacc[mi][4 * g] * bf_lo(gv[0]), oacc[mi][4 * g + 1] * bf_hi(gv[0]), oacc[mi][4 * g + 2] * bf_lo(gv[1]), oacc[mi][4 * g + 3] * bf_hi(gv[1]));
        }
    __syncthreads();
}

template <int G>
DI void pool_group(const Params& p, int l, int tok0, char* lds, int tid) {
    const int lane = tid & 63, w = tid >> 6, r = lane & 31, hi = lane >> 5;
    constexpr int wlen = 2 << G;
    const int tl = w * 32 + r, token = tok0 + tl, s = token & 4095;
    const short* px = (const short*)(p.ws + OFF_PX);
    const short* wp = (const short*)(p.ws + OFF_WTPOOL) + (size_t)(l * 4 + G) * 4096;
    short* mp = (short*)(p.ws + OFF_MIX) + (size_t)token * DM + 512 + G * 64;
    __syncthreads();
#pragma unroll
    for (int i = 0; i < 5; ++i) {
        const int c = tid + NT * i;
        if (c < 271 * 8) {
            const int row = c >> 3, ch = c & 7, tok = tok0 - 15 + row;
            u32x4 v = {0u, 0u, 0u, 0u};
            if (tok >= 0) v = *(const u32x4*)(px + (size_t)tok * 256 + G * 64 + ch * 8);
            *(u32x4*)(lds + swz(row, ch)) = v;
        }
    }
    __syncthreads();
    const int cnt = (s + 1 < wlen) ? (s + 1) : wlen;
    const float icnt = 1.f / (float)cnt;
    f32x16 oacc[2];
#pragma unroll
    for (int mi = 0; mi < 2; ++mi)
#pragma unroll
        for (int i = 0; i < 16; ++i) oacc[mi][i] = 0.f;
#pragma unroll 1
    for (int kk = 0; kk < 4; ++kk) {
        float sum[8], x0[8];
        {
            const u32x4 v = *(const u32x4*)(lds + swz(tl + 15, 2 * kk + hi));
#pragma unroll
            for (int q = 0; q < 4; ++q) { x0[2 * q] = bf_lo(v[q]); x0[2 * q + 1] = bf_hi(v[q]); sum[2 * q] = x0[2 * q]; sum[2 * q + 1] = x0[2 * q + 1]; }
        }
#pragma unroll
        for (int jj = 1; jj < wlen; ++jj) {
            const u32x4 v = *(const u32x4*)(lds + swz(tl + 15 - jj, 2 * kk + hi));
            const bool ok = jj < cnt;
#pragma unroll
            for (int q = 0; q < 4; ++q) { sum[2 * q] += ok ? bf_lo(v[q]) : 0.f; sum[2 * q + 1] += ok ? bf_hi(v[q]) : 0.f; }
        }
        const bf16x8 pfr = pack8(sum[0] * icnt - x0[0], sum[1] * icnt - x0[1], sum[2] * icnt - x0[2], sum[3] * icnt - x0[3],
                                 sum[4] * icnt - x0[4], sum[5] * icnt - x0[5], sum[6] * icnt - x0[6], sum[7] * icnt - x0[7]);
#pragma unroll
        for (int mi = 0; mi < 2; ++mi) {
            const bf16x8 wf = *(const bf16x8*)(wp + (32 * mi + r) * 64 + kk * 16 + hi * 8);
            oacc[mi] = MFMA32(wf, pfr, oacc[mi]);
        }
    }
#pragma unroll
    for (int mi = 0; mi < 2; ++mi)
#pragma unroll
        for (int gg = 0; gg < 4; ++gg) {
            const int d = 32 * mi + 8 * gg + 4 * hi;
            const u32x2 gv = *(const u32x2*)(mp + d);
            store4(mp + d, oacc[mi][4 * gg] * bf_lo(gv[0]), oacc[mi][4 * gg + 1] * bf_hi(gv[0]), oacc[mi][4 * gg + 2] * bf_lo(gv[1]), oacc[mi][4 * gg + 3] * bf_hi(gv[1]));
        }
}
DI void pool_unit(const Params& p, int l, int tt, char* lds, int tid) {
    pool_group<0>(p, l, tt * 256, lds, tid); pool_group<1>(p, l, tt * 256, lds, tid);
    pool_group<2>(p, l, tt * 256, lds, tid); pool_group<3>(p, l, tt * 256, lds, tid);
    __syncthreads();
}

DI void phase_mixers(const Params& p, int l, char* lds, int tid) {
    unsigned* ctr = (unsigned*)(p.ws + OFF_CTR) + l;
    volatile int* su = (volatile int*)(lds + LDS_MISC + 512);
    constexpr int U_FOX = 32 * 16, U_SB = 16 * 16, U_POOL = 64, U_CONV = 72;
    const int nconv = (l + 1 < NL) ? U_CONV : 0;
    bool g1 = false, g2 = false;
    for (;;) {
        __syncthreads();
        asm volatile("" : "+v"(tid));
        if (tid == 0) su[0] = (int)__hip_atomic_fetch_add(ctr, 1u, __ATOMIC_RELAXED, __HIP_MEMORY_SCOPE_AGENT);
        __syncthreads();
        int u = su[0];
        if (u >= U_FOX + U_SB + U_POOL + nconv) break;
        if (u >= U_FOX + U_SB + U_POOL) { convert_layer(p, l + 1, lds, tid, u - (U_FOX + U_SB + U_POOL), U_CONV); continue; }
        constexpr int FSPLIT = 5, U_F1 = 32 * (16 - FSPLIT);
        if (u >= U_F1 && u < U_FOX + U_SB) u = (u < U_F1 + U_SB) ? (u - U_F1 + U_FOX) : (u - U_SB);
        if (u < U_FOX) { if (!g1) { gate_wait(gate_ptr(p.ws, l, 0), gridDim.x, tid); g1 = true; } }
        else if (!g2) { gate_wait(gate_ptr(p.ws, l, 1), gridDim.x, tid); g1 = true; g2 = true; }
        if (u < U_FOX) fox_unit(p, l, u & 31, 15 - (u >> 5), lds, tid);
        else if (u < U_FOX + U_SB) { const int v = u - U_FOX; sb_unit(p, v & 15, 15 - (v >> 4), lds, tid); }
        else pool_unit(p, l, u - U_FOX - U_SB, lds, tid);
    }
}

__global__ void __launch_bounds__(NT, 2) mega(Params p, int ph_lo, int ph_hi) {
    extern __shared__ __attribute__((aligned(16))) char lds[];
    const int tid0 = threadIdx.x;
    if (p.use_cg) cg::this_grid().sync();
    XcdBarrier bar;
    volatile LAS unsigned* xbw = (volatile LAS unsigned*)(lds + LDS_MISC + 1024);
    if (ph_hi - ph_lo > 1) {
        if (tid0 < 4) xbw[tid0] = 0u;
        __syncthreads();
        bar = xcd_barrier_post((unsigned*)(p.ws + OFF_BAR), xbw);
    }
    for (int ph = ph_lo; ph < ph_hi; ++ph) {
        int tid = tid0; asm volatile("" : "+v"(tid));
        if (ph == 0) phase_prologue(p, lds, tid);
        else {
            const int l = (ph - 1) / 3, k = (ph - 1) % 3;
            if (k == 0) phase_inproj(p, l, lds, tid, bar.x, xbw[0]);
            else if (k == 1) phase_mixers(p, l, lds, tid);
            else phase_outproj(p, l, lds, tid);
        }
        if (ph + 1 < ph_hi && !(ph > 0 && (ph - 1) % 3 == 0)) {
            unsigned long long bp = (unsigned long long)(p.ws + OFF_BAR); asm volatile("" : "+s"(bp));
            bar.bar = (unsigned*)bp;
            xcd_barrier(bar);
        }
    }
}

extern "C" void kernel_launch(void* const* d_in, const int* in_sizes, int n_in, void* d_out, int out_size, void* d_ws, size_t ws_size, hipStream_t stream) {
    Params p{};
    p.x = (const float*)d_in[0]; p.norm_g = (const float*)d_in[1]; p.w_in = (const float*)d_in[2]; p.b_f = (const float*)d_in[3];
    p.qg = (const float*)d_in[4]; p.kg = (const float*)d_in[5]; p.w_pool = (const float*)d_in[6]; p.pool_scale = (const float*)d_in[7];
    p.w_out = (const float*)d_in[8]; p.out = (float*)d_out; p.ws = (char*)d_ws; p.use_cg = 0; p.pad = 0;
    if (ws_size < WS_NEED) { fprintf(stderr, "workspace too small: %zu < %zu\n", ws_size, WS_NEED); return; }
    static bool attr_set = false;
    if (!attr_set) {
        if (hipFuncSetAttribute((const void*)mega, hipFuncAttributeMaxDynamicSharedMemorySize, LDS_TOTAL) != hipSuccess) fprintf(stderr, "hipFuncSetAttribute failed\n");
        attr_set = true;
    }
    const int grid = 256;
    constexpr int NPH = 1 + 3 * NL;
    (void)hipMemsetAsync(d_ws, 0, 32768, stream);
    int lo = 0, hi = NPH;
    void* args[] = {&p, &lo, &hi};
    hipError_t e = hipLaunchCooperativeKernel((const void*)mega, dim3(grid), dim3(NT), args, LDS_TOTAL, stream);
    if (e != hipSuccess) fprintf(stderr, "cooperative launch failed: %s\n", hipGetErrorString(e));
}
```

```cpp
#include <hip/hip_runtime.h>
#include <hip/hip_cooperative_groups.h>
#include <cstdint>
#include <cstdio>
namespace cg = cooperative_groups;

#ifndef SB_EARLY_EXIT
#define SB_EARLY_EXIT 1
#endif
#ifndef FOX_SKIP
#define FOX_SKIP 1
#endif
#define DI __device__ __forceinline__
#define LAS __attribute__((address_space(3)))
typedef short bf16x8 __attribute__((ext_vector_type(8)));
typedef float f32x16 __attribute__((ext_vector_type(16)));
typedef float f32x4 __attribute__((ext_vector_type(4)));
typedef float f32x2 __attribute__((ext_vector_type(2)));
typedef unsigned u32x4 __attribute__((ext_vector_type(4)));
typedef unsigned u32x2 __attribute__((ext_vector_type(2)));
typedef __bf16 bf2_t __attribute__((ext_vector_type(2)));
#define MFMA32(a, b, c) __builtin_amdgcn_mfma_f32_32x32x16_bf16((a), (b), (c), 0, 0, 0)
#define PIN8(a) asm volatile("" : "+v"(a[0][0]), "+v"(a[0][1]), "+v"(a[0][2]), "+v"(a[0][3]), "+v"(a[1][0]), "+v"(a[1][1]), "+v"(a[1][2]), "+v"(a[1][3]))

constexpr int NB = 4, S = 4096, DM = 1024, NL = 4, T = NB * S, NT = 512;
constexpr int DIN = 3592, NP = 3584;
constexpr float LOG2E = 1.4426950408889634f;
constexpr float EPS = 1e-6f;

constexpr size_t OFF_BAR = 0;
constexpr size_t OFF_CTR = 16384;
constexpr size_t OFF_WTIN = 32768;
constexpr size_t OFF_WTOUT = OFF_WTIN + (size_t)NL * NP * DM * 2;
constexpr size_t OFF_WTPOOL = OFF_WTOUT + (size_t)NL * DM * DM * 2;
constexpr size_t OFF_WTFF = OFF_WTPOOL + (size_t)NL * 4 * 64 * 64 * 2;
constexpr size_t OFF_XB = OFF_WTFF + (size_t)NL * 16 * DM * 2;
constexpr size_t OFF_SSQ = OFF_XB + (size_t)T * DM * 2;
constexpr size_t OFF_QF = OFF_SSQ + (size_t)T * 16 * 4;
constexpr size_t OFF_KF = OFF_QF + (size_t)T * 512 * 2;
constexpr size_t OFF_VTF = OFF_KF + (size_t)T * 512 * 2;
constexpr size_t OFF_PX = OFF_VTF + (size_t)T * 512 * 2;
constexpr size_t OFF_SQ = OFF_PX + (size_t)T * 256 * 2;
constexpr size_t OFF_SK = OFF_SQ + (size_t)T * 256 * 2;
constexpr size_t OFF_SVT = OFF_SK + (size_t)T * 256 * 2;
constexpr size_t OFF_LOGF = OFF_SVT + (size_t)T * 256 * 2;
constexpr size_t OFF_MIX = OFF_LOGF + (size_t)NB * 8 * S * 4;
constexpr size_t WS_NEED = OFF_MIX + (size_t)T * DM * 2;

struct Params {
    const float *x, *norm_g, *w_in, *b_f, *qg, *kg, *w_pool, *pool_scale, *w_out;
    float* out; char* ws; int use_cg; int pad;
};

constexpr int LDS_MISC = 131072;
constexpr int LDS_TOTAL = LDS_MISC + 2048;

DI unsigned pk2(float a, float b) { f32x2 v = {a, b}; bf2_t r = __builtin_convertvector(v, bf2_t); return __builtin_bit_cast(unsigned, r); }
DI float bf_lo(unsigned u) { return __uint_as_float(u << 16); }
DI float bf_hi(unsigned u) { return __uint_as_float(u & 0xffff0000u); }
DI float fexp2(float x) { return __builtin_amdgcn_exp2f(x); }
DI float flog2(float x) { return __builtin_amdgcn_logf(x); }
DI float silu_f(float v) { return v * __builtin_amdgcn_rcpf(1.f + fexp2(-v * LOG2E)); }
DI int swz(int row, int chunk) { return row * 128 + ((chunk ^ ((row >> 1) & 7)) << 4); }
DI bf16x8 pack8(float a0, float a1, float a2, float a3, float a4, float a5, float a6, float a7) {
    u32x4 u = {pk2(a0, a1), pk2(a2, a3), pk2(a4, a5), pk2(a6, a7)}; return __builtin_bit_cast(bf16x8, u);
}
DI void store4(short* p, float a, float b, float c, float d) { u32x2 o = {pk2(a, b), pk2(c, d)}; *(u32x2*)p = o; }
DI void store8(short* p, const f32x4& a, const f32x4& b) { u32x4 o = {pk2(a[0], a[1]), pk2(a[2], a[3]), pk2(b[0], b[1]), pk2(b[2], b[3])}; *(u32x4*)p = o; }
#define XB_TMO      128
#define XB_XCNT(j)  (256  + 64 * (j))
#define XB_XSUB(j)  (1280 + 64 * (j))
#define XB_XGEN(j)  (2304 + 64 * (j))
#define XB_TOP      3328
#define XB_TOPGEN   3392
#define XCD_BAR_WORDS 3456
#define XB_SPIN_CAP (1u << 22)
DI unsigned xb_ld(unsigned* p)              { return __hip_atomic_load(p, __ATOMIC_RELAXED, __HIP_MEMORY_SCOPE_AGENT); }
DI unsigned xb_add(unsigned* p, unsigned v) { return __hip_atomic_fetch_add(p, v, __ATOMIC_RELAXED, __HIP_MEMORY_SCOPE_AGENT); }
DI unsigned xb_xcc_id() { return (unsigned)__builtin_amdgcn_readfirstlane((int)(__builtin_amdgcn_s_getreg((3 << 11) | 20) & 0xFu)); }
#define XB_SPIN(cond, bar) do { unsigned _sp = 0; while (cond) { __builtin_amdgcn_s_sleep(1); \
    if ((++_sp & 255u) == 0u) { if (xb_ld(&(bar)[XB_TMO])) break; if (_sp > XB_SPIN_CAP) { atomicAdd(&(bar)[XB_TMO], 1u); break; } } } } while (0)
struct XcdBarrier { unsigned* bar; unsigned x; volatile LAS unsigned* st; };
DI XcdBarrier xcd_barrier_post(unsigned* bar, volatile LAS unsigned* st) {
    XcdBarrier b; b.bar = bar; b.x = xb_xcc_id(); b.st = st;
    if (threadIdx.x == 0) (void)xb_add(&bar[XB_XCNT(b.x)], 1u);
    return b;
}
DI void xcd_barrier_complete(unsigned* bar, unsigned x, unsigned& nloc, unsigned& nx) {
    const unsigned G = gridDim.x * gridDim.y * gridDim.z;
    unsigned sum, cnt, mine, sp = 0u;
    for (;;) {
        sum = 0u; cnt = 0u; mine = 0u;
#pragma unroll
        for (unsigned j = 0; j < 16; ++j) { const unsigned c = xb_ld(&bar[XB_XCNT(j)]); sum += c; cnt += (c > 0u) ? 1u : 0u; mine = (j == x) ? c : mine; }
        if (sum == G) break;
        __builtin_amdgcn_s_sleep(1);
        if ((++sp & 255u) == 0u) { if (xb_ld(&bar[XB_TMO])) break; if (sp > XB_SPIN_CAP) { atomicAdd(&bar[XB_TMO], 1u); break; } }
    }
    nloc = mine > 0u ? mine : 1u; nx = cnt > 0u ? cnt : 1u;
}
DI void xcd_barrier(const XcdBarrier& b) {
    asm volatile("s_waitcnt vmcnt(0)" ::: "memory");
    __syncthreads();
    if (threadIdx.x == 0) {
        unsigned* bar = b.bar;
        __builtin_amdgcn_s_waitcnt(0);
        unsigned nloc = b.st[0], nx = b.st[1];
        if (nloc == 0u) { xcd_barrier_complete(bar, b.x, nloc, nx); b.st[0] = nloc; b.st[1] = nx; }
        const unsigned old = xb_add(&bar[XB_XSUB(b.x)], 1u);
        const unsigned gen = old / nloc;
        if (old + 1u == (gen + 1u) * nloc) {
            __builtin_amdgcn_fence(__ATOMIC_RELEASE, "agent");
            asm volatile("s_waitcnt vmcnt(0)" ::: "memory");
            const unsigned og = xb_add(&bar[XB_TOP], 1u);
            const unsigned tg = og / nx;
            if (og + 1u == (tg + 1u) * nx) xb_add(&bar[XB_TOPGEN], 1u);
            else XB_SPIN(xb_ld(&bar[XB_TOPGEN]) == tg, bar);
            __builtin_amdgcn_fence(__ATOMIC_ACQUIRE, "agent");
            xb_add(&bar[XB_XGEN(b.x)], 1u);
            asm volatile("s_waitcnt vmcnt(0)" ::: "memory");
        } else {
            XB_SPIN(xb_ld(&bar[XB_XGEN(b.x)]) == gen, bar);
            __builtin_amdgcn_fence(__ATOMIC_ACQUIRE, "agent");
            asm volatile("s_waitcnt vmcnt(0)" ::: "memory");
        }
    }
    __syncthreads();
}

namespace pg8 {
#define PG8_LAS __attribute__((address_space(3)))
typedef unsigned short bf16_t;
typedef short bf16x8 __attribute__((ext_vector_type(8)));
typedef float f32x4 __attribute__((ext_vector_type(4)));
typedef unsigned u32x4 __attribute__((ext_vector_type(4)));
constexpr int BM = 256, BK = 64, HALF = 128, HTB = HALF * BK * 2  , STAGE_BYTES = 8 * HTB, NXCD = 8, WGM = 8;

__host__ __device__ __forceinline__ int lds_byte(int r, int c) { const int st = (r >> 4) * 2 + (c >> 5), rr = r & 15, cc = c & 31, ob = rr * 64 + cc * 2; return st * 1024 + (ob ^ (((ob >> 9) & 1) << 5)); }
__host__ __device__ __forceinline__ void stage_rc(int b, int& R, int& C) { const int st = b / 1024, sb = b % 1024, swz = sb ^ (((sb >> 9) & 1) << 5); R = (st >> 1) * 16 + swz / 64; C = (st & 1) * 32 + (swz % 64) / 2; }
__host__ __device__ __forceinline__ int perm32(int rho) { const int n = rho >> 4, i = rho & 15; return 8 * (i >> 2) + 4 * n + (i & 3); }

struct Unit { int pm, pn; };
struct Gemm { const bf16_t* A; const bf16_t* Bt; int M, N, K; };

struct StaticOrder {
    int nM, nN, nwg, G, c;
    __host__ __device__ void init(int M, int N, int G_, int c_) { nM = M / BM; nN = N / BM; nwg = nM * nN; G = G_; c = c_; }
    __host__ __device__ bool next(int i, Unit& u) const {
        const long L = (long)i * G + c; if (L >= nwg) return false;
        int wgid = (int)L; { const int q = nwg / NXCD, r = nwg % NXCD, xcd = wgid % NXCD, off = wgid / NXCD; wgid = (xcd < r ? xcd * (q + 1) : r * (q + 1) + (xcd - r) * q) + off; }
        const int nig = WGM * nN, gid = wgid / nig, fm = gid * WGM, gsz = (nM - fm) < WGM ? (nM - fm) : WGM;
        u.pm = fm + ((wgid % nig) % gsz); u.pn = (wgid % nig) / gsz; return true;
    }
    __device__ __forceinline__ void a_ready(const Unit&) const {}
    __device__ __forceinline__ void done(const Unit&) const {}
};
template <class Epi, class Sched, bool ALIGN_EPI = false, bool SP2 = false>
__device__ __forceinline__ void gemm_phase(PG8_LAS unsigned char* lds, const Gemm g, const Sched& S, const Epi& E) {
    int tid = threadIdx.x; asm volatile("" : "+v"(tid));
    const int wid = __builtin_amdgcn_readfirstlane(tid >> 6), lane = tid & 63, wr = wid >> 2, wc = wid & 3, fr = lane & 15, fq = lane >> 4;
    const int K = g.K, nt = K / BK;
    unsigned voffA[2], voffB[2];
#pragma unroll
    for (int i = 0; i < 2; ++i) { int R, C; stage_rc(tid * 16 + i * 8192, R, C); const int Rb = Epi::PERM ? ((R & ~31) + perm32(R & 31)) : R;
        voffA[i] = (unsigned)(R * K + C) * 2u; voffB[i] = (unsigned)(Rb * K + C) * 2u; }
    const size_t kstep = (size_t)(BK * 2);
    const size_t hstep = (size_t)HALF * K * 2;
    const size_t tstep = 2 * hstep;
    const unsigned ldsw = (unsigned)wid * 1024u;
    const int aoff = lds_byte(wr * 64 + fr, fq * 8), boff = lds_byte(wc * 32 + fr, fq * 8);
#define PG8_SA(b, h) (((b) * 2 + (h)) * HTB)
#define PG8_SB(b, h) ((4 + (b) * 2 + (h)) * HTB)
#define PG8_STAGE(bufoff, gbase, voff) do { _Pragma("unroll") for (int _i = 0; _i < 2; ++_i) \
        __builtin_amdgcn_global_load_lds((const unsigned*)((const char*)(gbase) + (voff)[_i]), (PG8_LAS unsigned*)(lds + (bufoff) + ldsw + _i * 8192), 16, 0, 0); } while (0)
#define PG8_LDA(dst, b, h) do { _Pragma("unroll") for (int m = 0; m < 4; ++m) _Pragma("unroll") for (int k = 0; k < 2; ++k) dst[m][k] = *(const PG8_LAS bf16x8*)(lds + PG8_SA(b, h) + aoff + m * 2048 + k * 1024); } while (0)
#define PG8_LDB(dst, b, h) do { _Pragma("unroll") for (int n = 0; n < 2; ++n) _Pragma("unroll") for (int k = 0; k < 2; ++k) dst[n][k] = *(const PG8_LAS bf16x8*)(lds + PG8_SB(b, h) + boff + n * 2048 + k * 1024); } while (0)
#define PG8_MMA(ai, bj, At, Bt) do { __builtin_amdgcn_s_setprio(1); _Pragma("unroll") for (int m = 0; m < 4; ++m) _Pragma("unroll") for (int n = 0; n < 2; ++n) _Pragma("unroll") for (int k = 0; k < 2; ++k) \
        acc[ai][bj][m][n] = __builtin_amdgcn_mfma_f32_16x16x32_bf16(Bt[n][k], At[m][k], acc[ai][bj][m][n], 0, 0, 0); __builtin_amdgcn_s_setprio(0); } while (0)
#define PG8_WAIT_V(n) asm volatile("s_waitcnt vmcnt(" #n ")" ::: "memory")
#define PG8_WAIT_L(n) asm volatile("s_waitcnt lgkmcnt(" #n ")" ::: "memory")
#define PG8_BAR __builtin_amdgcn_s_barrier()
#define PG8_SCHED __builtin_amdgcn_sched_barrier(0)
    Unit cur, nxt; int ui = 0;
    if (!S.next(0, cur)) return;
    f32x4 acc[2][2][4][2];
#pragma unroll
    for (int a = 0; a < 2; ++a)
#pragma unroll
        for (int b = 0; b < 2; ++b)
#pragma unroll
            for (int m = 0; m < 4; ++m)
#pragma unroll
                for (int n = 0; n < 2; ++n) acc[a][b][m][n] = (f32x4){0.f, 0.f, 0.f, 0.f};
    bf16x8 At[4][2], B0[2][2], B1[2][2];
    const char* cA = (const char*)g.A + (size_t)cur.pm * tstep; const char* cB = (const char*)g.Bt + (size_t)cur.pn * tstep;
    S.a_ready(cur);
    if constexpr (SP2) {
        PG8_STAGE(PG8_SB(0, 0), cB, voffB); PG8_STAGE(PG8_SB(0, 1), cB + hstep, voffB); PG8_STAGE(PG8_SA(0, 0), cA, voffA); PG8_STAGE(PG8_SA(0, 1), cA + hstep, voffA);
        if (wr == 1) PG8_BAR;
        PG8_WAIT_V(2); PG8_BAR;
        PG8_STAGE(PG8_SB(1, 0), cB + kstep, voffB); PG8_STAGE(PG8_SA(1, 0), cA + kstep, voffA); PG8_STAGE(PG8_SB(1, 1), cB + hstep + kstep, voffB);
        PG8_WAIT_V(6); PG8_BAR;
    } else {
        PG8_STAGE(PG8_SB(0, 0), cB, voffB); PG8_STAGE(PG8_SA(0, 0), cA, voffA); PG8_STAGE(PG8_SB(0, 1), cB + hstep, voffB); PG8_STAGE(PG8_SA(0, 1), cA + hstep, voffA);
        if (wr == 1) PG8_BAR;
        PG8_WAIT_V(4); PG8_BAR;
        PG8_STAGE(PG8_SB(1, 0), cB + kstep, voffB); PG8_STAGE(PG8_SA(1, 0), cA + kstep, voffA); PG8_STAGE(PG8_SB(1, 1), cB + hstep + kstep, voffB);
        PG8_WAIT_V(6); PG8_BAR;
    }
    for (;;) {
        const bool has_next = S.next(ui + 1, nxt);
        const char* nA = has_next ? (const char*)g.A + (size_t)nxt.pm * tstep : cA; const char* nB = has_next ? (const char*)g.Bt + (size_t)nxt.pn * tstep : cB;
        for (int t = 0; t < nt; t += 2) {
            const bool last = (t == nt - 2);
            const char* a1 = cA + (size_t)(t + 1) * kstep;
            const char* a2 = last ? nA : cA + (size_t)(t + 2) * kstep; const char* b2 = last ? nB : cB + (size_t)(t + 2) * kstep;
            const char* a3 = a2 + kstep; const char* b3 = b2 + kstep;
            if (last && has_next) S.a_ready(nxt);
            if constexpr (SP2) {
            PG8_LDB(B0, 0, 0); PG8_LDB(B1, 0, 1); PG8_SCHED; PG8_LDA(At, 0, 0); PG8_STAGE(PG8_SA(1, 1), a1 + hstep, voffA);
            PG8_WAIT_V(8); PG8_WAIT_L(0); PG8_BAR; PG8_MMA(0, 0, At, B0); PG8_MMA(0, 1, At, B1); PG8_BAR; PG8_SCHED;
            PG8_LDA(At, 0, 1); PG8_STAGE(PG8_SB(0, 0), b2, voffB); PG8_STAGE(PG8_SB(0, 1), b2 + hstep, voffB); PG8_STAGE(PG8_SA(0, 0), a2, voffA);
            PG8_WAIT_V(8); PG8_WAIT_L(0); PG8_BAR; PG8_MMA(1, 0, At, B0); PG8_MMA(1, 1, At, B1); PG8_BAR; PG8_SCHED;
            PG8_LDB(B0, 1, 0); PG8_LDB(B1, 1, 1); PG8_SCHED; PG8_LDA(At, 1, 0); PG8_STAGE(PG8_SA(0, 1), a2 + hstep, voffA);
            PG8_WAIT_V(8); PG8_WAIT_L(0); PG8_BAR; PG8_MMA(0, 0, At, B0); PG8_MMA(0, 1, At, B1); PG8_BAR; PG8_SCHED;
            PG8_LDA(At, 1, 1); PG8_STAGE(PG8_SB(1, 0), b3, voffB); PG8_STAGE(PG8_SB(1, 1), b3 + hstep, voffB); PG8_STAGE(PG8_SA(1, 0), a3, voffA);
            PG8_WAIT_V(8); PG8_WAIT_L(0); PG8_BAR; PG8_MMA(1, 0, At, B0); PG8_MMA(1, 1, At, B1); PG8_BAR; PG8_SCHED;
            } else {
            PG8_LDB(B0, 0, 0); PG8_SCHED; PG8_LDA(At, 0, 0); PG8_STAGE(PG8_SA(1, 1), a1 + hstep, voffA);
            PG8_WAIT_L(8); PG8_BAR; PG8_WAIT_L(0); PG8_MMA(0, 0, At, B0); PG8_BAR; PG8_SCHED;
            PG8_LDB(B1, 0, 1); PG8_STAGE(PG8_SB(0, 0), b2, voffB);
            PG8_BAR; PG8_WAIT_L(0); PG8_MMA(0, 1, At, B1); PG8_BAR;
            PG8_LDA(At, 0, 1); PG8_STAGE(PG8_SA(0, 0), a2, voffA);
            PG8_BAR; PG8_WAIT_L(0); PG8_MMA(1, 0, At, B0); PG8_BAR; PG8_SCHED;
            PG8_STAGE(PG8_SB(0, 1), b2 + hstep, voffB);
            PG8_WAIT_V(6); PG8_BAR; PG8_MMA(1, 1, At, B1); PG8_BAR;
            PG8_LDB(B0, 1, 0); PG8_SCHED; PG8_LDA(At, 1, 0); PG8_STAGE(PG8_SA(0, 1), a2 + hstep, voffA);
            PG8_WAIT_L(8); PG8_BAR; PG8_WAIT_L(0); PG8_MMA(0, 0, At, B0); PG8_BAR; PG8_SCHED;
            PG8_LDB(B1, 1, 1); PG8_STAGE(PG8_SB(1, 0), b3, voffB);
            PG8_BAR; PG8_WAIT_L(0); PG8_MMA(0, 1, At, B1); PG8_BAR;
            PG8_LDA(At, 1, 1); PG8_STAGE(PG8_SA(1, 0), a3, voffA);
            PG8_BAR; PG8_WAIT_L(0); PG8_MMA(1, 0, At, B0); PG8_BAR; PG8_SCHED;
            PG8_STAGE(PG8_SB(1, 1), b3 + hstep, voffB);
            PG8_WAIT_V(6); PG8_BAR; PG8_MMA(1, 1, At, B1); PG8_BAR;
            }
        }
        if constexpr (ALIGN_EPI) { if (wr == 0) PG8_BAR; }
        if constexpr (!Epi::AFTER_DRAIN) { E(acc, cur, wr, wc, fr, fq); S.done(cur); }
        if (!has_next) break;
#pragma unroll
        for (int a = 0; a < 2; ++a)
#pragma unroll
            for (int b = 0; b < 2; ++b)
#pragma unroll
                for (int m = 0; m < 4; ++m)
#pragma unroll
                    for (int n = 0; n < 2; ++n) acc[a][b][m][n] = (f32x4){0.f, 0.f, 0.f, 0.f};
        cur = nxt; cA = nA; cB = nB; ++ui;
        if constexpr (ALIGN_EPI) { if (wr == 1) PG8_BAR; }
    }
    PG8_WAIT_V(0);
    if constexpr (!ALIGN_EPI) { if (wr == 0) PG8_BAR; }
    PG8_BAR;
    if constexpr (Epi::AFTER_DRAIN) { E.fused(acc, cur, wr, wc, fr, fq, lds, wid, lane); S.done(cur); }
#undef PG8_SA
#undef PG8_SB
#undef PG8_STAGE
#undef PG8_LDA
#undef PG8_LDB
#undef PG8_MMA
#undef PG8_WAIT_V
#undef PG8_WAIT_L
#undef PG8_BAR
#undef PG8_SCHED
}
}

DI unsigned* gate_ptr(const char* ws, int l, int k) { return (unsigned*)(ws + OFF_CTR) + 1024 + (l * 2 + k) * 320; }
DI void gate_arrive(unsigned* g, int tid, unsigned xcc, unsigned nloc) {
    asm volatile("s_waitcnt vmcnt(0)" ::: "memory");
    __syncthreads();
    if (tid == 0) {
        const unsigned old = xb_add(g + 16 * (xcc + 1), 1u);
        if (old + 1u == nloc) {
            __builtin_amdgcn_fence(__ATOMIC_RELEASE, "agent");
            asm volatile("s_waitcnt vmcnt(0)" ::: "memory");
            (void)xb_add(g, nloc);
        }
    }
}
DI void gate_wait(unsigned* g, unsigned target, int tid) {
    if (tid == 0) {
        unsigned sp = 0;
        while (xb_ld(g) < target) { __builtin_amdgcn_s_sleep(2); if (++sp > (1u << 24)) break; }
        __builtin_amdgcn_fence(__ATOMIC_ACQUIRE, "agent");
        asm volatile("s_waitcnt vmcnt(0)" ::: "memory");
    }
    __syncthreads();
}

DI int inproj_srccol(int np) {
    const int pn = np >> 8, c = np & 255, bj = c >> 7, wc = (c & 127) >> 5, j = c & 31;
    const int nlog = pn * 256 + 64 * wc + 32 * bj + j;
    return nlog < 2048 ? nlog : nlog + 8;
}
template <int MODE>
DI void transpose_tile(const float* src, int lds_, int k0, const float* gk, const float* gn, short* dst, int ldd, int n0, float* tile, int tid) {
    __syncthreads();
    {
        const int n4 = (tid & 15) * 4, kq = tid >> 4;
        const int col = (MODE == 0) ? inproj_srccol(n0 + n4) : (n0 + n4);
        f32x4 gnv = {1.f, 1.f, 1.f, 1.f};
        if (gn) gnv = *(const f32x4*)(gn + n0 + n4);
#pragma unroll
        for (int i = 0; i < 2; ++i) {
            const int k = i * 32 + kq;
            f32x4 v = *(const f32x4*)(src + (size_t)(k0 + k) * lds_ + col);
            const float g = gk ? gk[k0 + k] : 1.f;
            v = v * gnv * g;
            tile[k * 65 + n4] = v[0]; tile[k * 65 + n4 + 1] = v[1]; tile[k * 65 + n4 + 2] = v[2]; tile[k * 65 + n4 + 3] = v[3];
        }
    }
    __syncthreads();
    {
        const int n = tid >> 3, k8 = (tid & 7) * 8;
        u32x4 o;
#pragma unroll
        for (int q = 0; q < 4; ++q) o[q] = pk2(tile[(k8 + 2 * q) * 65 + n], tile[(k8 + 2 * q + 1) * 65 + n]);
        *(u32x4*)(dst + (size_t)(n0 + n) * ldd + k0 + k8) = o;
    }
}

DI void convert_layer(const Params& p, int l, char* lds, int tid, int vb, int nb) {
    float* tile = (float*)lds;
    short* wtin = (short*)(p.ws + OFF_WTIN) + (size_t)l * NP * DM; short* wtout = (short*)(p.ws + OFF_WTOUT) + (size_t)l * DM * DM;
    short* wtpool = (short*)(p.ws + OFF_WTPOOL) + (size_t)l * 4 * 4096; short* wtff = (short*)(p.ws + OFF_WTFF) + (size_t)l * 16 * DM;
    for (int e = vb * NT + tid; e < 16 * DM; e += nb * NT) {
        const int f = e >> 10, k = e & (DM - 1);
        const float v = (f < 8) ? p.w_in[((size_t)l * DM + k) * DIN + 2048 + f] * p.norm_g[l * DM + k] : 0.f;
        wtff[e] = (short)(pk2(v, 0.f) & 0xffffu);
    }
    if (vb == 0 && tid < 64) {
        float gq = fabsf(p.qg[l * 64 + tid]), gk = fabsf(p.kg[l * 64 + tid]);
#pragma unroll
        for (int d = 32; d >= 1; d >>= 1) { gq = fmaxf(gq, __shfl_xor(gq, d)); gk = fmaxf(gk, __shfl_xor(gk, d)); }
        if (tid == 0) ((float*)(p.ws + OFF_CTR))[3968 + l] = 8.f * gq * gk * LOG2E * 1.02f + 0.25f;
    }
    constexpr int U_IN = 16 * 56, U_OUT = 16 * 16, U_POOL = 4;
    for (int u = vb; u < U_IN + U_OUT + U_POOL; u += nb) {
        if (u < U_IN) {
            const int ntile = u / 16, kt = u % 16;
            transpose_tile<0>(p.w_in + (size_t)l * DM * DIN, DIN, kt * 64, p.norm_g + l * DM, nullptr, wtin, DM, ntile * 64, tile, tid);
        } else if (u < U_IN + U_OUT) {
            const int v = u - U_IN; const int ntile = v / 16, kt = v % 16;
            transpose_tile<1>(p.w_out + (size_t)l * DM * DM, DM, kt * 64, nullptr, nullptr, wtout, DM, ntile * 64, tile, tid);
        } else {
            const int g = u - U_IN - U_OUT;
            transpose_tile<1>(p.w_pool + (size_t)(l * 4 + g) * 4096, 64, 0, nullptr, p.pool_scale + l * 256 + g * 64, wtpool + (size_t)g * 4096, 64, 0, tile, tid);
        }
    }
    __syncthreads();
}

DI void phase_prologue(const Params& p, char* lds, int tid) {
    if (blockIdx.x == 0 && tid < 16) ((unsigned*)(p.ws + OFF_CTR))[tid] = 0u;
    convert_layer(p, 0, lds, tid, (int)blockIdx.x, (int)gridDim.x);
    short* xb = (short*)(p.ws + OFF_XB); float* ssq = (float*)(p.ws + OFF_SSQ);
    const int lane = tid & 63, w = tid >> 6;
    for (int row = blockIdx.x * 8 + w; row < T; row += gridDim.x * 8) {
        const float* xr = p.x + (size_t)row * DM;
        float ss = 0.f;
#pragma unroll
        for (int j = 0; j < 4; ++j) {
            const f32x4 v = *(const f32x4*)(xr + j * 256 + lane * 4);
            ss += v[0] * v[0] + v[1] * v[1] + v[2] * v[2] + v[3] * v[3];
            u32x2 o = {pk2(v[0], v[1]), pk2(v[2], v[3])};
            *(u32x2*)(xb + (size_t)row * DM + j * 256 + lane * 4) = o;
        }
#pragma unroll
        for (int d = 32; d >= 1; d >>= 1) ss += __shfl_xor(ss, d);
        if (lane < 16) ssq[(size_t)row * 16 + lane] = (lane == 0) ? ss : 0.f;
    }
}

typedef float pf32x4 __attribute__((ext_vector_type(4)));
DI float row_rstd(const float* ssq, int row, int fq) {
    const f32x4 v = *(const f32x4*)(ssq + (size_t)row * 16 + 4 * fq);
    float s = (v[0] + v[1]) + (v[2] + v[3]);
    s += __shfl_xor(s, 16); s += __shfl_xor(s, 32);
    return __builtin_amdgcn_rsqf(s * (1.f / 1024.f) + EPS);
}
struct EpiIn {
    static constexpr bool PERM = true, AFTER_DRAIN = false;
    char* ws; const float* qg; const float* kg;
    DI void operator()(const pg8::f32x4 (&acc)[2][2][4][2], const pg8::Unit& u, int wr, int wc, int fr, int fq) const {
        asm volatile("" : "+v"(fr), "+v"(fq));
        const int pn = u.pn;
        const float* ssq = (const float*)(ws + OFF_SSQ);
        float rstdv[2][4];
        {
            f32x4 sv[2][4];
#pragma unroll
            for (int ai = 0; ai < 2; ++ai)
#pragma unroll
                for (int m = 0; m < 4; ++m) sv[ai][m] = *(const f32x4*)(ssq + (size_t)(u.pm * 256 + ai * 128 + wr * 64 + m * 16 + fr) * 16 + 4 * fq);
            PIN8(sv);
#pragma unroll
            for (int ai = 0; ai < 2; ++ai)
#pragma unroll
                for (int m = 0; m < 4; ++m) {
                    float sx = (sv[ai][m][0] + sv[ai][m][1]) + (sv[ai][m][2] + sv[ai][m][3]);
                    sx += __shfl_xor(sx, 16); sx += __shfl_xor(sx, 32);
                    rstdv[ai][m] = __builtin_amdgcn_rsqf(sx * (1.f / 1024.f) + EPS);
                }
        }
#pragma unroll
        for (int ai = 0; ai < 2; ++ai)
#pragma unroll
            for (int m = 0; m < 4; ++m) {
                const int row = u.pm * 256 + ai * 128 + wr * 64 + m * 16 + fr;
                const float rstd = rstdv[ai][m];
                const int b = row >> 12, s = row & 4095;
                if (pn < 4) {
                    float ss = 0.f;
#pragma unroll
                    for (int bj = 0; bj < 2; ++bj)
#pragma unroll
                        for (int n = 0; n < 2; ++n)
#pragma unroll
                            for (int c = 0; c < 4; ++c) { const float v = acc[ai][bj][m][n][c]; ss += v * v; }
                    ss += __shfl_xor(ss, 16); ss += __shfl_xor(ss, 32);
                    ss *= rstd * rstd;
                    const float rn = __builtin_amdgcn_rsqf(ss * (1.f / 64.f) + EPS) * rstd * (pn < 2 ? 0.125f * LOG2E : 1.f);
                    const float* gv = (pn < 2) ? qg : kg;
                    short* dst = (short*)(ws + (pn < 2 ? OFF_QF : OFF_KF)) + ((size_t)(b * 8 + (pn & 1) * 4 + wc) * S + s) * 64;
#pragma unroll
                    for (int bj = 0; bj < 2; ++bj) {
                        const int d = 32 * bj + 8 * fq;
                        const f32x4 g0 = *(const f32x4*)(gv + d), g1 = *(const f32x4*)(gv + d + 4);
                        const f32x4 v0 = acc[ai][bj][m][0] * (g0 * rn), v1 = acc[ai][bj][m][1] * (g1 * rn);
                        store8(dst + d, v0, v1);
                    }
                } else if (pn == 4 || pn == 5 || pn == 12) {
                    short* base = (pn == 12) ? ((short*)(ws + OFF_SVT) + ((size_t)(b * 4 + wc) * 64) * S)
                                             : ((short*)(ws + OFF_VTF) + ((size_t)(b * 8 + (pn - 4) * 4 + wc) * 64) * S);
#pragma unroll
                    for (int bj = 0; bj < 2; ++bj)
#pragma unroll
                        for (int n = 0; n < 2; ++n)
#pragma unroll
                            for (int c = 0; c < 4; c += 2) {
                                const int d = 32 * bj + 8 * fq + 4 * n + c;
                                const unsigned pk = pk2(acc[ai][bj][m][n][c] * rstd, acc[ai][bj][m][n][c + 1] * rstd);
                                base[(size_t)d * S + s] = (short)(pk & 0xffffu);
                                base[(size_t)(d + 1) * S + s] = (short)(pk >> 16);
                            }
                } else {
                    short* dst; bool dosilu = false; float sc = rstd;
                    if (pn == 6 || pn == 7) { dst = (short*)(ws + OFF_MIX) + (size_t)row * DM + (pn - 6) * 256 + wc * 64; }
                    else if (pn == 8) { dst = (short*)(ws + OFF_PX) + (size_t)row * 256 + wc * 64; }
                    else if (pn == 9) { dst = (short*)(ws + OFF_MIX) + (size_t)row * DM + 512 + wc * 64; }
                    else if (pn == 10) { dst = (short*)(ws + OFF_SQ) + ((size_t)(b * 4 + wc) * S + s) * 64; sc = rstd * 0.125f * LOG2E; }
                    else if (pn == 11) { dst = (short*)(ws + OFF_SK) + ((size_t)(b * 4 + wc) * S + s) * 64; }
                    else { dst = (short*)(ws + OFF_MIX) + (size_t)row * DM + 768 + wc * 64; }
#pragma unroll
                    for (int bj = 0; bj < 2; ++bj) {
                        f32x4 v0 = acc[ai][bj][m][0] * sc, v1 = acc[ai][bj][m][1] * sc;
                        if (dosilu) {
#pragma unroll
                            for (int c = 0; c < 4; ++c) { v0[c] = silu_f(v0[c]); v1[c] = silu_f(v1[c]); }
                        }
                        store8(dst + 32 * bj + 8 * fq, v0, v1);
                    }
                }
            }
    }
};
struct EpiOut {
    static constexpr bool PERM = true, AFTER_DRAIN = false;
    const float* res32; float* out; short* xb; float* ssq; int first; int last;
    DI void operator()(const pg8::f32x4 (&acc)[2][2][4][2], const pg8::Unit& u, int wr, int wc, int fr, int fq) const {
        asm volatile("" : "+v"(fr), "+v"(fq));
#pragma unroll
        for (int ai = 0; ai < 2; ++ai) {
            u32x4 rb[2][4];
            if (!first) {
#pragma unroll
                for (int m = 0; m < 4; ++m)
#pragma unroll
                    for (int bj = 0; bj < 2; ++bj)
                        rb[bj][m] = *(const u32x4*)(xb + (size_t)(u.pm * 256 + ai * 128 + wr * 64 + m * 16 + fr) * DM + u.pn * 256 + bj * 128 + wc * 32 + fq * 8);
                PIN8(rb);
            }
#pragma unroll
            for (int m = 0; m < 4; ++m) {
                const int row = u.pm * 256 + ai * 128 + wr * 64 + m * 16 + fr;
                float ss = 0.f;
#pragma unroll
                for (int bj = 0; bj < 2; ++bj) {
                    const size_t off = (size_t)row * DM + u.pn * 256 + bj * 128 + wc * 32 + fq * 8;
                    f32x4 r0, r1;
                    if (first) { r0 = *(const f32x4*)(res32 + off); r1 = *(const f32x4*)(res32 + off + 4); }
                    else {
                        const u32x4 rv = rb[bj][m];
                        r0 = (f32x4){bf_lo(rv[0]), bf_hi(rv[0]), bf_lo(rv[1]), bf_hi(rv[1])}; r1 = (f32x4){bf_lo(rv[2]), bf_hi(rv[2]), bf_lo(rv[3]), bf_hi(rv[3])};
                    }
                    const f32x4 o0 = r0 + acc[ai][bj][m][0], o1 = r1 + acc[ai][bj][m][1];
                    if (last) { *(f32x4*)(out + off) = o0; *(f32x4*)(out + off + 4) = o1; }
                    else {
                        ss += (o0[0] * o0[0] + o0[1] * o0[1]) + (o0[2] * o0[2] + o0[3] * o0[3]) + (o1[0] * o1[0] + o1[1] * o1[1]) + (o1[2] * o1[2] + o1[3] * o1[3]);
                        store8(xb + off, o0, o1);
                    }
                }
                if (!last) { ss += __shfl_xor(ss, 16); ss += __shfl_xor(ss, 32); if (fq == 0) ssq[(size_t)row * 16 + u.pn * 4 + wc] = ss; }
            }
        }
    }
};

DI void ff_job(const Params& p, int l, int tb, int tid) {
    const int lane = tid & 63, w = tid >> 6, fr = lane & 15, fq = lane >> 4;
    const int tok = tb * 128 + w * 16 + fr;
    const short* wff = (const short*)(p.ws + OFF_WTFF) + (size_t)l * 16 * DM + fr * DM + fq * 8;
    const short* xr = (const short*)(p.ws + OFF_XB) + (size_t)tok * DM + fq * 8;
    pg8::f32x4 acc = {0.f, 0.f, 0.f, 0.f};
#pragma unroll 16
    for (int ks = 0; ks < 32; ++ks) {
        const bf16x8 a = *(const bf16x8*)(wff + ks * 32), bq = *(const bf16x8*)(xr + ks * 32);
        acc = __builtin_amdgcn_mfma_f32_16x16x32_bf16(a, bq, acc, 0, 0, 0);
    }
    const float* sp = (const float*)(p.ws + OFF_SSQ) + (size_t)tok * 16;
    const f32x4 s0 = *(const f32x4*)sp, s1 = *(const f32x4*)(sp + 4), s2 = *(const f32x4*)(sp + 8), s3 = *(const f32x4*)(sp + 12);
    const float ssum = ((s0[0] + s0[1]) + (s0[2] + s0[3])) + ((s1[0] + s1[1]) + (s1[2] + s1[3])) + ((s2[0] + s2[1]) + (s2[2] + s2[3])) + ((s3[0] + s3[1]) + (s3[2] + s3[3]));
    const float rstd = __builtin_amdgcn_rsqf(ssum * (1.f / 1024.f) + EPS);
    if (fq < 2) {
        const int b = tok >> 12, s = tok & 4095;
        float* LOGF = (float*)(p.ws + OFF_LOGF);
#pragma unroll
        for (int i = 0; i < 4; ++i) {
            const int f = 4 * fq + i;
            const float v = acc[i] * rstd + p.b_f[l * 8 + f];
            LOGF[(size_t)(b * 8 + f) * S + s] = fminf(v, 0.f) - log1pf(expf(-fabsf(v)));
        }
    }
}

struct InSchedA {
    pg8::StaticOrder s;
    __device__ bool next(int i, pg8::Unit& u) const { if (!s.next(i, u)) return false; u.pn = (u.pn < 9) ? u.pn : u.pn + 1; return true; }
    DI void a_ready(const pg8::Unit&) const {}
    DI void done(const pg8::Unit&) const {}
};
struct InSchedB {
    pg8::StaticOrder s;
    __device__ bool next(int i, pg8::Unit& u) const { if (!s.next(i, u)) return false; u.pn = u.pn ? 13 : 9; return true; }
    DI void a_ready(const pg8::Unit&) const {}
    DI void done(const pg8::Unit&) const {}
};
DI void phase_inproj(const Params& p, int l, char* lds, int tid, unsigned xcc, unsigned nloc) {
    const int G = gridDim.x, c = (int)blockIdx.x;
    for (int tb = G - 1 - c; tb < 128; tb += G) ff_job(p, l, tb, tid);
    pg8::Gemm g{(const pg8::bf16_t*)(p.ws + OFF_XB), (const pg8::bf16_t*)(p.ws + OFF_WTIN) + (size_t)l * NP * DM, T, NP, DM};
    EpiIn E{p.ws, p.qg + l * 64, p.kg + l * 64};
    { InSchedA Sa; Sa.s.init(T, 12 * 256, G, c); pg8::gemm_phase<EpiIn, InSchedA, true, true>((PG8_LAS unsigned char*)lds, g, Sa, E); }
    gate_arrive(gate_ptr(p.ws, l, 0), tid, xcc, nloc);
    { InSchedB Sb; Sb.s.init(T, 2 * 256, G, c); pg8::gemm_phase<EpiIn, InSchedB, true, true>((PG8_LAS unsigned char*)lds, g, Sb, E); }
    gate_arrive(gate_ptr(p.ws, l, 1), tid, xcc, nloc);
}
DI void phase_outproj(const Params& p, int l, char* lds, int tid) {
    const int G = gridDim.x;
    pg8::Gemm g{(const pg8::bf16_t*)(p.ws + OFF_MIX), (const pg8::bf16_t*)(p.ws + OFF_WTOUT) + (size_t)l * DM * DM, T, DM, DM};
    pg8::StaticOrder So; So.init(T, DM, G, (int)blockIdx.x);
    EpiOut E{p.x, p.out, (short*)(p.ws + OFF_XB), (float*)(p.ws + OFF_SSQ), (l == 0) ? 1 : 0, (l + 1 == NL) ? 1 : 0};
    pg8::gemm_phase<EpiOut, pg8::StaticOrder, true, true>((PG8_LAS unsigned char*)lds, g, So, E);
}

constexpr int STG_BYTES = 16384, RING_OFF = 16384;
DI void glds16(const void* gsrc, unsigned lds_dst) {
    unsigned keep;
    asm volatile("s_mov_b32 %0, m0\n\ts_mov_b32 m0, %2\n\ts_nop 0\n\tglobal_load_lds_dwordx4 %1, off\n\ts_mov_b32 m0, %0" : "=&s"(keep) : "v"(gsrc), "s"(lds_dst) : "memory");
}
DI void kv_dma(const short* Kb, const short* Vtb, int j, char* stage, int tid) {
    const int w = tid >> 6, row = tid >> 3, ch = (tid & 7) ^ ((row >> 1) & 7);
    const unsigned dst = (unsigned)__builtin_amdgcn_readfirstlane((int)(unsigned)(size_t)(LAS char*)stage + w * 1024);
    glds16(Kb + (size_t)(64 * j + row) * 64 + ch * 8, dst);
    glds16(Vtb + (size_t)row * S + 64 * j + ch * 8, dst + 8192u);
}
DI void kv_wait_bar(int rem) {
    if (rem >= 2) asm volatile("s_waitcnt vmcnt(4)\n\ts_waitcnt lgkmcnt(0)\n\ts_barrier" ::: "memory");
    else if (rem == 1) asm volatile("s_waitcnt vmcnt(2)\n\ts_waitcnt lgkmcnt(0)\n\ts_barrier" ::: "memory");
    else asm volatile("s_waitcnt vmcnt(0)\n\ts_waitcnt lgkmcnt(0)\n\ts_barrier" ::: "memory");
}

DI void fox_qk(const char* kb, const float* cp, const bf16x8 (&qf)[4], float bt, int krow, int hi, f32x16 (&sacc)[2]) {
    bf16x8 kf[2][4];
#pragma unroll
    for (int sub = 0; sub < 2; ++sub)
#pragma unroll
        for (int kk = 0; kk < 4; ++kk) kf[sub][kk] = *(const bf16x8*)(kb + swz(32 * sub + krow, 2 * kk + hi));
    f32x4 cv[2][4];
#pragma unroll
    for (int sub = 0; sub < 2; ++sub)
#pragma unroll
        for (int q4 = 0; q4 < 4; ++q4) cv[sub][q4] = *(const f32x4*)(cp + 32 * sub + 4 * q4);
    PIN8(kf); PIN8(cv);
#pragma unroll
    for (int sub = 0; sub < 2; ++sub)
#pragma unroll
        for (int q4 = 0; q4 < 4; ++q4) {
            sacc[sub][4 * q4] = bt - cv[sub][q4][0]; sacc[sub][4 * q4 + 1] = bt - cv[sub][q4][1]; sacc[sub][4 * q4 + 2] = bt - cv[sub][q4][2]; sacc[sub][4 * q4 + 3] = bt - cv[sub][q4][3];
        }
    __builtin_amdgcn_s_setprio(1);
#pragma unroll
    for (int kk = 0; kk < 4; ++kk)
#pragma unroll
        for (int sub = 0; sub < 2; ++sub) sacc[sub] = MFMA32(kf[sub][kk], qf[kk], sacc[sub]);
    __builtin_amdgcn_s_setprio(0);
}
template <bool MASK>
DI void fox_sm(const f32x16 (&sacc)[2], int lim, float& lsum, bf16x8 (&pf)[2][2]) {
#pragma unroll
    for (int sub = 0; sub < 2; ++sub) {
        float pr[16];
#pragma unroll
        for (int i = 0; i < 16; ++i) {
            float pv = fexp2(sacc[sub][i]);
            if (MASK) { if (i + 32 * sub > lim) pv = 0.f; }
            pr[i] = pv;
        }
        pf[sub][0] = pack8(pr[0], pr[1], pr[2], pr[3], pr[4], pr[5], pr[6], pr[7]);
        pf[sub][1] = pack8(pr[8], pr[9], pr[10], pr[11], pr[12], pr[13], pr[14], pr[15]);
    }
}
DI void fox_pv(const char* vb, int r, int hi, const bf16x8 (&pf)[2][2], f32x16 (&oacc)[2], f32x16& lacc) {
    bf16x8 vf[2][4];
#pragma unroll
    for (int mi = 0; mi < 2; ++mi)
#pragma unroll
        for (int c = 0; c < 4; ++c) vf[mi][c] = *(const bf16x8*)(vb + swz(32 * mi + r, 4 * (c >> 1) + 2 * hi + (c & 1)));
    PIN8(vf);
    const u32x4 onesu = {0x3f803f80u, 0x3f803f80u, 0x3f803f80u, 0x3f803f80u};
    const bf16x8 ones = __builtin_bit_cast(bf16x8, onesu);
    __builtin_amdgcn_s_setprio(1);
#pragma unroll
    for (int c = 0; c < 4; ++c) {
#pragma unroll
        for (int mi = 0; mi < 2; ++mi) oacc[mi] = MFMA32(vf[mi][c], pf[c >> 1][c & 1], oacc[mi]);
        lacc = MFMA32(ones, pf[c >> 1][c & 1], lacc);
    }
    __builtin_amdgcn_s_setprio(0);
}
DI void fox_unit(const Params& p, int l, int bh, int qb, char* lds, int tid) {
    const int lane = tid & 63, w = tid >> 6, r = lane & 31, hi = lane >> 5;
    float* cs = (float*)lds; char* ring = lds + RING_OFF; float* misc = (float*)(lds + LDS_MISC);
    const short* Kb = (const short*)(p.ws + OFF_KF) + (size_t)bh * S * 64;
    const short* Vtb = (const short*)(p.ws + OFF_VTF) + (size_t)bh * 64 * S;
    const int kmax = (qb + 1) * 256, jmax = 4 * qb + 3;
    kv_dma(Kb, Vtb, jmax, ring, tid);
    const float M2 = ((const float*)(p.ws + OFF_CTR))[3968 + l];
    const int qrow = qb * 256 + w * 32 + r;
    bf16x8 qf[4];
    {
        const short* qp = (const short*)(p.ws + OFF_QF) + ((size_t)bh * S + qrow) * 64 + hi * 8;
#pragma unroll
        for (int kk = 0; kk < 4; ++kk) qf[kk] = *(const bf16x8*)(qp + kk * 16);
    }
    {
        const float* lf = (const float*)(p.ws + OFF_LOGF) + (size_t)bh * S + tid * 8;
        float v[8];
        if (tid * 8 < kmax) {
#pragma unroll
            for (int q = 0; q < 2; ++q) { const f32x4 t4 = *(const f32x4*)(lf + 4 * q); v[4 * q] = t4[0]; v[4 * q + 1] = t4[1]; v[4 * q + 2] = t4[2]; v[4 * q + 3] = t4[3]; }
        } else {
#pragma unroll
            for (int q = 0; q < 8; ++q) v[q] = 0.f;
        }
#pragma unroll
        for (int q = 1; q < 8; ++q) v[q] += v[q - 1];
        const float tot = v[7];
        float sc = tot;
#pragma unroll
        for (int d = 1; d < 64; d <<= 1) { const float t2 = __shfl_up(sc, d); if (lane >= d) sc += t2; }
        if (lane == 63) misc[w] = sc;
        __syncthreads();
        float off = sc - tot;
        for (int j = 0; j < w; ++j) off += misc[j];
#pragma unroll
        for (int q = 0; q < 8; ++q) cs[tid * 8 + q] = (off + v[q]) * LOG2E;
    }
    __syncthreads();
    int jlo = 0;
#if FOX_SKIP
    {
        const float cq = cs[qb * 256];
        const bool c = (lane <= jmax) && (cq - cs[64 * lane + 63] < -(152.f + 2.f * M2));
        const unsigned long long mask = __ballot(c);
        jlo = mask ? (64 - __builtin_clzll(mask)) : 0;
        if (jlo > jmax) jlo = jmax;
    }
#endif
    int jloww = jlo;
#if FOX_SKIP
    {
        const float cqw = cs[qb * 256 + w * 32];
        const bool c2 = (lane <= jmax) && (cqw - cs[64 * lane + 63] < -(152.f + 2.f * M2));
        const unsigned long long mask2 = __ballot(c2);
        jloww = mask2 ? (64 - __builtin_clzll(mask2)) : 0;
        const int jdiag = (qb * 256 + w * 32) >> 6;
        if (jloww > jdiag) jloww = jdiag;
        if (jloww < jlo) jloww = jlo;
    }
#endif
    float bt = cs[qrow] - M2;
    asm volatile("" : "+v"(qf[0]), "+v"(qf[1]), "+v"(qf[2]), "+v"(qf[3]), "+v"(bt));
    asm volatile("s_waitcnt vmcnt(0)" ::: "memory");
#pragma unroll
    for (int t = 1; t < 4; ++t) if (jmax - t >= jlo) kv_dma(Kb, Vtb, jmax - t, ring + t * STG_BYTES, tid);
    f32x16 oacc[2];
#pragma unroll
    for (int mi = 0; mi < 2; ++mi)
#pragma unroll
        for (int i = 0; i < 16; ++i) oacc[mi][i] = 0.f;
    float lsum = 0.f;
    f32x16 lacc;
#pragma unroll
    for (int i = 0; i < 16; ++i) lacc[i] = 0.f;
    const int qmin = qb * 256 + w * 32;
    const int krow = 16 * ((r >> 2) & 1) + 4 * (r >> 3) + (r & 3);
    const int ntl = jmax - jlo + 1;
    const int nch = (ntl + 1) >> 1;
    for (int c = 0; c < nch; ++c) {
        const int nnext = (2 * c + 3 < ntl) ? 2 : ((2 * c + 2 < ntl) ? 1 : 0);
        kv_wait_bar(nnext);
        {
            const int t0 = 2 * c + 4;
            if (t0 < ntl) kv_dma(Kb, Vtb, jmax - t0, ring + (t0 % 6) * STG_BYTES, tid);
            if (t0 + 1 < ntl) kv_dma(Kb, Vtb, jmax - t0 - 1, ring + ((t0 + 1) % 6) * STG_BYTES, tid);
        }
#pragma unroll
        for (int h2 = 0; h2 < 2; ++h2) {
            const int t = 2 * c + h2;
            const int key0 = 64 * (jmax - t);
            if (t < ntl && key0 <= qmin + 31 && (jmax - t) >= jloww) {
                const char* stg = ring + (t % 6) * STG_BYTES;
                f32x16 sc[2];
                fox_qk(stg, cs + key0 + 16 * hi, qf, bt, krow, hi, sc);
                bf16x8 pf[2][2];
                if (key0 + 63 > qmin) fox_sm<true>(sc, qrow - key0 - 16 * hi, lsum, pf); else fox_sm<false>(sc, 0, lsum, pf);
                fox_pv(stg + 8192, r, hi, pf, oacc, lacc);
            }
        }
    }
    lsum = lacc[0];
    const float inv = __builtin_amdgcn_rcpf(lsum);
    const int b = bh >> 3, h = bh & 7;
    short* mp = (short*)(p.ws + OFF_MIX) + (size_t)(b * S + qrow) * DM + h * 64;
#pragma unroll
    for (int mi = 0; mi < 2; ++mi)
#pragma unroll
        for (int g = 0; g < 4; ++g) {
            const int d = 32 * mi + 8 * g + 4 * hi;
            const u32x2 gv = *(const u32x2*)(mp + d);
            store4(mp + d, oacc[mi][4 * g] * inv * silu_f(bf_lo(gv[0])), oacc[mi][4 * g + 1] * inv * silu_f(bf_hi(gv[0])), oacc[mi][4 * g + 2] * inv * silu_f(bf_lo(gv[1])), oacc[mi][4 * g + 3] * inv * silu_f(bf_hi(gv[1])));
        }
}

template <bool MASK>
DI void sb_tile(const char* kb, const bf16x8 (&qf)[4], int krow, int r, int hi, int lim, f32x16 (&oacc)[2], float& Rc) {
    const char* vb = kb + 8192;
    bf16x8 kf[2][4];
#pragma unroll
    for (int sub = 0; sub < 2; ++sub)
#pragma unroll
        for (int kk = 0; kk < 4; ++kk) kf[sub][kk] = *(const bf16x8*)(kb + swz(32 * sub + krow, 2 * kk + hi));
    PIN8(kf);
    f32x16 z[2];
#pragma unroll
    for (int sub = 0; sub < 2; ++sub) {
#pragma unroll
        for (int i = 0; i < 16; ++i) z[sub][i] = 0.f;
#pragma unroll
        for (int kk = 0; kk < 4; ++kk) z[sub] = MFMA32(kf[sub][kk], qf[kk], z[sub]);
    }
    bf16x8 vf[2][4];
#pragma unroll
    for (int mi = 0; mi < 2; ++mi)
#pragma unroll
        for (int c = 0; c < 4; ++c) vf[mi][c] = *(const bf16x8*)(vb + swz(32 * mi + r, 4 * (c >> 1) + 2 * hi + (c & 1)));
    PIN8(vf);
    float Tt[2];
#pragma unroll
    for (int sub = 1; sub >= 0; --sub) {
        float run = 0.f;
#pragma unroll
        for (int i = 15; i >= 0; --i) {
            const float zz = z[sub][i];
            const float e = fexp2(-fabsf(zz));
            float sp = fmaxf(zz, 0.f) + flog2(1.f + e);
            float val = zz + (run - sp);
            if (MASK) { if (i + 32 * sub >= lim) { sp = 0.f; val = -INFINITY; } }
            z[sub][i] = val;
            run -= sp;
        }
        Tt[sub] = run;
    }
    const float T1p = __shfl_xor(Tt[1], 32), T0p = __shfl_xor(Tt[0], 32);
    const float sum1 = Tt[1] + T1p;
    float off[2];
    off[1] = Rc + (hi == 0 ? T1p : 0.f);
    off[0] = Rc + sum1 + (hi == 0 ? T0p : 0.f);
    Rc = Rc + sum1 + Tt[0] + T0p;
    bf16x8 pf[2][2];
#pragma unroll
    for (int sub = 0; sub < 2; ++sub) {
        float pr[16];
#pragma unroll
        for (int i = 0; i < 16; ++i) pr[i] = fexp2(z[sub][i] + off[sub]);
        pf[sub][0] = pack8(pr[0], pr[1], pr[2], pr[3], pr[4], pr[5], pr[6], pr[7]);
        pf[sub][1] = pack8(pr[8], pr[9], pr[10], pr[11], pr[12], pr[13], pr[14], pr[15]);
    }
#pragma unroll
    for (int c = 0; c < 4; ++c)
#pragma unroll
        for (int mi = 0; mi < 2; ++mi) oacc[mi] = MFMA32(vf[mi][c], pf[c >> 1][c & 1], oacc[mi]);
}

DI void sb_unit(const Params& p, int bh, int qb, char* lds, int tid) {
    const int lane = tid & 63, w = tid >> 6, r = lane & 31, hi = lane >> 5;
    char* ring = lds + RING_OFF; volatile int* flags = (volatile int*)(lds + LDS_MISC + 256);
    const short* Kb = (const short*)(p.ws + OFF_SK) + (size_t)bh * S * 64;
    const short* Vtb = (const short*)(p.ws + OFF_SVT) + (size_t)bh * 64 * S;
    const int jmax = 4 * qb + 3;
    const int qrow = qb * 256 + w * 32 + r;
    bf16x8 qf[4];
    {
        const short* qp = (const short*)(p.ws + OFF_SQ) + ((size_t)bh * S + qrow) * 64 + hi * 8;
#pragma unroll
        for (int kk = 0; kk < 4; ++kk) qf[kk] = *(const bf16x8*)(qp + kk * 16);
    }
    asm volatile("" : "+v"(qf[0]), "+v"(qf[1]), "+v"(qf[2]), "+v"(qf[3]));
    asm volatile("s_waitcnt vmcnt(0)" ::: "memory");
    __syncthreads();
    f32x16 oacc[2];
#pragma unroll
    for (int mi = 0; mi < 2; ++mi)
#pragma unroll
        for (int i = 0; i < 16; ++i) oacc[mi][i] = 0.f;
    float Rc = 0.f;
    const int qmin = qb * 256 + w * 32;
    const int krow = 16 * ((r >> 2) & 1) + 4 * (r >> 3) + (r & 3);
    const int nwin = (jmax + 1 < 8) ? (jmax + 1) : 8;
#pragma unroll
    for (int t = 0; t < 8; ++t) if (t < nwin) kv_dma(Kb, Vtb, jmax - t, lds + t * STG_BYTES, tid);
    asm volatile("s_waitcnt vmcnt(0)\n\ts_barrier" ::: "memory");
    const int tw = 3 - (w >> 1);
    bool wdone = false;
    for (int t = 0; t < nwin; ++t) {
        if (t >= tw && !wdone) {
            const int key0 = 64 * (jmax - t);
            const char* kb = lds + t * STG_BYTES;
            if (key0 + 63 >= qmin) sb_tile<true>(kb, qf, krow, r, hi, qrow - key0 - 16 * hi, oacc, Rc);
            else sb_tile<false>(kb, qf, krow, r, hi, 0, oacc, Rc);
            wdone = __all(Rc < -152.f);
        }
    }
    if (lane == 0) flags[16 + w] = wdone ? 1 : 0;
    __syncthreads();
    int ndw = 0;
#pragma unroll
    for (int q = 0; q < 8; ++q) ndw += flags[16 + q];
    const int jstart = jmax - 8;
    if (ndw < 8 && jstart >= 0) {
#pragma unroll
        for (int t = 0; t < 3; ++t) if (jstart - t >= 0) kv_dma(Kb, Vtb, jstart - t, ring + t * STG_BYTES, tid);
        int it = 0;
        for (int j = jstart; j >= 0; --j, ++it) {
            const int cur = it & 1;
            kv_wait_bar(j);
            if (j >= 3) kv_dma(Kb, Vtb, j - 3, ring + ((it + 3) & 3) * STG_BYTES, tid);
            if (it > 0) {
                int nd = 0;
#pragma unroll
                for (int q = 0; q < 8; ++q) nd += flags[(cur ^ 1) * 8 + q];
                if (nd == 8) break;
            }
            if (!wdone) {
                sb_tile<false>(ring + (it & 3) * STG_BYTES, qf, krow, r, hi, 0, oacc, Rc);
                wdone = __all(Rc < -152.f);
            }
            if (lane == 0) flags[cur * 8 + w] = wdone ? 1 : 0;
        }
        asm volatile("s_waitcnt vmcnt(0)" ::: "memory");
    }
    const int b = bh >> 2, h = bh & 3;
    short* mp = (short*)(p.ws + OFF_MIX) + (size_t)(b * S + qrow) * DM + 768 + h * 64;
#pragma unroll
    for (int mi = 0; mi < 2; ++mi)
#pragma unroll
        for (int g = 0; g < 4; ++g) {
            const int d = 32 * mi + 8 * g + 4 * hi;
            const u32x2 gv = *(const u32x2*)(mp + d);
            store4(mp + d, oacc[mi][4 * g] * silu_f(bf_lo(gv[0])), oacc[mi][4 * g + 1] * silu_f(bf_hi(gv[0])), oacc[mi][4 * g + 2] * silu_f(bf_lo(gv[1])), oacc[mi][4 * g + 3] * silu_f(bf_hi(gv[1])));
        }
    __syncthreads();
}

template <int G>
DI void pool_group(const Params& p, int l, int tok0, char* lds, int tid) {
    const int lane = tid & 63, w = tid >> 6, r = lane & 31, hi = lane >> 5;
    constexpr int wlen = 2 << G;
    const int tl = w * 32 + r, token = tok0 + tl, s = token & 4095;
    const short* px = (const short*)(p.ws + OFF_PX);
    const short* wp = (const short*)(p.ws + OFF_WTPOOL) + (size_t)(l * 4 + G) * 4096;
    short* mp = (short*)(p.ws + OFF_MIX) + (size_t)token * DM + 512 + G * 64;
    __syncthreads();
#pragma unroll
    for (int i = 0; i < 5; ++i) {
        const int c = tid + NT * i;
        if (c < 271 * 8) {
            const int row = c >> 3, ch = c & 7, tok = tok0 - 15 + row;
            u32x4 v = {0u, 0u, 0u, 0u};
            if (tok >= 0) v = *(const u32x4*)(px + (size_t)tok * 256 + G * 64 + ch * 8);
            *(u32x4*)(lds + swz(row, ch)) = v;
        }
    }
    __syncthreads();
    const int cnt = (s + 1 < wlen) ? (s + 1) : wlen;
    const float icnt = 1.f / (float)cnt;
    f32x16 oacc[2];
#pragma unroll
    for (int mi = 0; mi < 2; ++mi)
#pragma unroll
        for (int i = 0; i < 16; ++i) oacc[mi][i] = 0.f;
#pragma unroll 1
    for (int kk = 0; kk < 4; ++kk) {
        float sum[8], x0[8];
        {
            const u32x4 v = *(const u32x4*)(lds + swz(tl + 15, 2 * kk + hi));
#pragma unroll
            for (int q = 0; q < 4; ++q) { x0[2 * q] = bf_lo(v[q]); x0[2 * q + 1] = bf_hi(v[q]); sum[2 * q] = x0[2 * q]; sum[2 * q + 1] = x0[2 * q + 1]; }
        }
#pragma unroll
        for (int jj = 1; jj < wlen; ++jj) {
            const u32x4 v = *(const u32x4*)(lds + swz(tl + 15 - jj, 2 * kk + hi));
            const bool ok = jj < cnt;
#pragma unroll
            for (int q = 0; q < 4; ++q) { sum[2 * q] += ok ? bf_lo(v[q]) : 0.f; sum[2 * q + 1] += ok ? bf_hi(v[q]) : 0.f; }
        }
        const bf16x8 pfr = pack8(sum[0] * icnt - x0[0], sum[1] * icnt - x0[1], sum[2] * icnt - x0[2], sum[3] * icnt - x0[3],
                                 sum[4] * icnt - x0[4], sum[5] * icnt - x0[5], sum[6] * icnt - x0[6], sum[7] * icnt - x0[7]);
#pragma unroll
        for (int mi = 0; mi < 2; ++mi) {
            const bf16x8 wf = *(const bf16x8*)(wp + (32 * mi + r) * 64 + kk * 16 + hi * 8);
            oacc[mi] = MFMA32(wf, pfr, oacc[mi]);
        }
    }
#pragma unroll
    for (int mi = 0; mi < 2; ++mi)
#pragma unroll
        for (int gg = 0; gg < 4; ++gg) {
            const int d = 32 * mi + 8 * gg + 4 * hi;
            const u32x2 gv = *(const u32x2*)(mp + d);
            store4(mp + d, oacc[mi][4 * gg] * silu_f(bf_lo(gv[0])), oacc[mi][4 * gg + 1] * silu_f(bf_hi(gv[0])), oacc[mi][4 * gg + 2] * silu_f(bf_lo(gv[1])), oacc[mi][4 * gg + 3] * silu_f(bf_hi(gv[1])));
        }
}
DI void pool_unit(const Params& p, int l, int tt, char* lds, int tid) {
    pool_group<0>(p, l, tt * 256, lds, tid); pool_group<1>(p, l, tt * 256, lds, tid);
    pool_group<2>(p, l, tt * 256, lds, tid); pool_group<3>(p, l, tt * 256, lds, tid);
    __syncthreads();
}

DI void phase_mixers(const Params& p, int l, char* lds, int tid) {
    unsigned* ctr = (unsigned*)(p.ws + OFF_CTR) + l;
    volatile int* su = (volatile int*)(lds + LDS_MISC + 512);
    constexpr int U_FOX = 32 * 16, U_SB = 16 * 16, U_POOL = 64, U_CONV = 72;
    const int nconv = (l + 1 < NL) ? U_CONV : 0;
    bool g1 = false, g2 = false;
    for (;;) {
        __syncthreads();
        asm volatile("" : "+v"(tid));
        if (tid == 0) su[0] = (int)__hip_atomic_fetch_add(ctr, 1u, __ATOMIC_RELAXED, __HIP_MEMORY_SCOPE_AGENT);
        __syncthreads();
        int u = su[0];
        if (u >= U_FOX + U_SB + U_POOL + nconv) break;
        if (u >= U_FOX + U_SB + U_POOL) { convert_layer(p, l + 1, lds, tid, u - (U_FOX + U_SB + U_POOL), U_CONV); continue; }
        constexpr int FSPLIT = 5, U_F1 = 32 * (16 - FSPLIT);
        if (u >= U_F1 && u < U_FOX + U_SB) u = (u < U_F1 + U_SB) ? (u - U_F1 + U_FOX) : (u - U_SB);
        if (u < U_FOX) { if (!g1) { gate_wait(gate_ptr(p.ws, l, 0), gridDim.x, tid); g1 = true; } }
        else if (!g2) { gate_wait(gate_ptr(p.ws, l, 1), gridDim.x, tid); g1 = true; g2 = true; }
        if (u < U_FOX) fox_unit(p, l, u & 31, 15 - (u >> 5), lds, tid);
        else if (u < U_FOX + U_SB) { const int v = u - U_FOX; sb_unit(p, v & 15, 15 - (v >> 4), lds, tid); }
        else pool_unit(p, l, u - U_FOX - U_SB, lds, tid);
    }
}

__global__ void __launch_bounds__(NT, 2) mega(Params p, int ph_lo, int ph_hi) {
    extern __shared__ __attribute__((aligned(16))) char lds[];
    const int tid0 = threadIdx.x;
    if (p.use_cg) cg::this_grid().sync();
    XcdBarrier bar;
    volatile LAS unsigned* xbw = (volatile LAS unsigned*)(lds + LDS_MISC + 1024);
    if (ph_hi - ph_lo > 1) {
        if (tid0 < 4) xbw[tid0] = 0u;
        __syncthreads();
        bar = xcd_barrier_post((unsigned*)(p.ws + OFF_BAR), xbw);
    }
    for (int ph = ph_lo; ph < ph_hi; ++ph) {
        int tid = tid0; asm volatile("" : "+v"(tid));
        if (ph == 0) phase_prologue(p, lds, tid);
        else {
            const int l = (ph - 1) / 3, k = (ph - 1) % 3;
            if (k == 0) phase_inproj(p, l, lds, tid, bar.x, xbw[0]);
            else if (k == 1) phase_mixers(p, l, lds, tid);
            else phase_outproj(p, l, lds, tid);
        }
        if (ph + 1 < ph_hi && !(ph > 0 && (ph - 1) % 3 == 0)) {
            unsigned long long bp = (unsigned long long)(p.ws + OFF_BAR); asm volatile("" : "+s"(bp));
            bar.bar = (unsigned*)bp;
            xcd_barrier(bar);
        }
    }
}

extern "C" void kernel_launch(void* const* d_in, const int* in_sizes, int n_in, void* d_out, int out_size, void* d_ws, size_t ws_size, hipStream_t stream) {
    Params p{};
    p.x = (const float*)d_in[0]; p.norm_g = (const float*)d_in[1]; p.w_in = (const float*)d_in[2]; p.b_f = (const float*)d_in[3];
    p.qg = (const float*)d_in[4]; p.kg = (const float*)d_in[5]; p.w_pool = (const float*)d_in[6]; p.pool_scale = (const float*)d_in[7];
    p.w_out = (const float*)d_in[8]; p.out = (float*)d_out; p.ws = (char*)d_ws; p.use_cg = 0; p.pad = 0;
    if (ws_size < WS_NEED) { fprintf(stderr, "workspace too small: %zu < %zu\n", ws_size, WS_NEED); return; }
    static bool attr_set = false;
    if (!attr_set) {
        if (hipFuncSetAttribute((const void*)mega, hipFuncAttributeMaxDynamicSharedMemorySize, LDS_TOTAL) != hipSuccess) fprintf(stderr, "hipFuncSetAttribute failed\n");
        attr_set = true;
    }
    const int grid = 256;
    constexpr int NPH = 1 + 3 * NL;
    (void)hipMemsetAsync(d_ws, 0, 32768, stream);
    int lo = 0, hi = NPH;
    void* args[] = {&p, &lo, &hi};
    hipError_t e = hipLaunchCooperativeKernel((const void*)mega, dim3(grid), dim3(NT), args, LDS_TOTAL, stream);
    if (e != hipSuccess) fprintf(stderr, "cooperative launch failed: %s\n", hipGetErrorString(e));
}
```

```cpp
#include <hip/hip_runtime.h>
#include <hip/hip_cooperative_groups.h>
#include <cstdint>
#include <cstdio>
namespace cg = cooperative_groups;

#ifndef SB_EARLY_EXIT
#define SB_EARLY_EXIT 1
#endif
#ifndef FOX_SKIP
#define FOX_SKIP 1
#endif
#define DI __device__ __forceinline__
#define LAS __attribute__((address_space(3)))
typedef short bf16x8 __attribute__((ext_vector_type(8)));
typedef float f32x16 __attribute__((ext_vector_type(16)));
typedef float f32x4 __attribute__((ext_vector_type(4)));
typedef float f32x2 __attribute__((ext_vector_type(2)));
typedef unsigned u32x4 __attribute__((ext_vector_type(4)));
typedef unsigned u32x2 __attribute__((ext_vector_type(2)));
typedef __bf16 bf2_t __attribute__((ext_vector_type(2)));
#define MFMA32(a, b, c) __builtin_amdgcn_mfma_f32_32x32x16_bf16((a), (b), (c), 0, 0, 0)
#define PIN8(a) asm volatile("" : "+v"(a[0][0]), "+v"(a[0][1]), "+v"(a[0][2]), "+v"(a[0][3]), "+v"(a[1][0]), "+v"(a[1][1]), "+v"(a[1][2]), "+v"(a[1][3]))

constexpr int NB = 4, S = 4096, DM = 1024, NL = 4, T = NB * S, NT = 512;
constexpr int DIN = 3592, NP = 3584;
constexpr float LOG2E = 1.4426950408889634f;
constexpr float EPS = 1e-6f;

constexpr size_t OFF_BAR = 0;
constexpr size_t OFF_CTR = 16384;
constexpr size_t OFF_WTIN = 32768;
constexpr size_t OFF_WTOUT = OFF_WTIN + (size_t)NL * NP * DM * 2;
constexpr size_t OFF_WTPOOL = OFF_WTOUT + (size_t)NL * DM * DM * 2;
constexpr size_t OFF_WTFF = OFF_WTPOOL + (size_t)NL * 4 * 64 * 64 * 2;
constexpr size_t OFF_XB = OFF_WTFF + (size_t)NL * 16 * DM * 2;
constexpr size_t OFF_SSQ = OFF_XB + (size_t)T * DM * 2;
constexpr size_t OFF_QF = OFF_SSQ + (size_t)T * 16 * 4;
constexpr size_t OFF_KF = OFF_QF + (size_t)T * 512 * 2;
constexpr size_t OFF_VTF = OFF_KF + (size_t)T * 512 * 2;
constexpr size_t OFF_PX = OFF_VTF + (size_t)T * 512 * 2;
constexpr size_t OFF_SQ = OFF_PX + (size_t)T * 256 * 2;
constexpr size_t OFF_SK = OFF_SQ + (size_t)T * 256 * 2;
constexpr size_t OFF_SVT = OFF_SK + (size_t)T * 256 * 2;
constexpr size_t OFF_LOGF = OFF_SVT + (size_t)T * 256 * 2;
constexpr size_t OFF_MIX = OFF_LOGF + (size_t)NB * 8 * S * 4;
constexpr size_t WS_NEED = OFF_MIX + (size_t)T * DM * 2;

struct Params {
    const float *x, *norm_g, *w_in, *b_f, *qg, *kg, *w_pool, *pool_scale, *w_out;
    float* out; char* ws; int use_cg; int pad;
};

constexpr int LDS_MISC = 131072;
constexpr int LDS_TOTAL = LDS_MISC + 2048;

DI unsigned pk2(float a, float b) { f32x2 v = {a, b}; bf2_t r = __builtin_convertvector(v, bf2_t); return __builtin_bit_cast(unsigned, r); }
DI float bf_lo(unsigned u) { return __uint_as_float(u << 16); }
DI float bf_hi(unsigned u) { return __uint_as_float(u & 0xffff0000u); }
DI float fexp2(float x) { return __builtin_amdgcn_exp2f(x); }
DI float flog2(float x) { return __builtin_amdgcn_logf(x); }
DI float silu_f(float v) { return v * __builtin_amdgcn_rcpf(1.f + fexp2(-v * LOG2E)); }
DI int swz(int row, int chunk) { return row * 128 + ((chunk ^ ((row >> 1) & 7)) << 4); }
DI bf16x8 pack8(float a0, float a1, float a2, float a3, float a4, float a5, float a6, float a7) {
    u32x4 u = {pk2(a0, a1), pk2(a2, a3), pk2(a4, a5), pk2(a6, a7)}; return __builtin_bit_cast(bf16x8, u);
}
DI void store4(short* p, float a, float b, float c, float d) { u32x2 o = {pk2(a, b), pk2(c, d)}; *(u32x2*)p = o; }
DI void store8(short* p, const f32x4& a, const f32x4& b) { u32x4 o = {pk2(a[0], a[1]), pk2(a[2], a[3]), pk2(b[0], b[1]), pk2(b[2], b[3])}; *(u32x4*)p = o; }
#define XB_TMO      128
#define XB_XCNT(j)  (256  + 64 * (j))
#define XB_XSUB(j)  (1280 + 64 * (j))
#define XB_XGEN(j)  (2304 + 64 * (j))
#define XB_TOP      3328
#define XB_TOPGEN   3392
#define XCD_BAR_WORDS 3456
#define XB_SPIN_CAP (1u << 22)
DI unsigned xb_ld(unsigned* p)              { return __hip_atomic_load(p, __ATOMIC_RELAXED, __HIP_MEMORY_SCOPE_AGENT); }
DI unsigned xb_add(unsigned* p, unsigned v) { return __hip_atomic_fetch_add(p, v, __ATOMIC_RELAXED, __HIP_MEMORY_SCOPE_AGENT); }
DI unsigned xb_xcc_id() { return (unsigned)__builtin_amdgcn_readfirstlane((int)(__builtin_amdgcn_s_getreg((3 << 11) | 20) & 0xFu)); }
#define XB_SPIN(cond, bar) do { unsigned _sp = 0; while (cond) { __builtin_amdgcn_s_sleep(1); \
    if ((++_sp & 255u) == 0u) { if (xb_ld(&(bar)[XB_TMO])) break; if (_sp > XB_SPIN_CAP) { atomicAdd(&(bar)[XB_TMO], 1u); break; } } } } while (0)
struct XcdBarrier { unsigned* bar; unsigned x; volatile LAS unsigned* st; };
DI XcdBarrier xcd_barrier_post(unsigned* bar, volatile LAS unsigned* st) {
    XcdBarrier b; b.bar = bar; b.x = xb_xcc_id(); b.st = st;
    if (threadIdx.x == 0) (void)xb_add(&bar[XB_XCNT(b.x)], 1u);
    return b;
}
DI void xcd_barrier_complete(unsigned* bar, unsigned x, unsigned& nloc, unsigned& nx) {
    const unsigned G = gridDim.x * gridDim.y * gridDim.z;
    unsigned sum, cnt, mine, sp = 0u;
    for (;;) {
        sum = 0u; cnt = 0u; mine = 0u;
#pragma unroll
        for (unsigned j = 0; j < 16; ++j) { const unsigned c = xb_ld(&bar[XB_XCNT(j)]); sum += c; cnt += (c > 0u) ? 1u : 0u; mine = (j == x) ? c : mine; }
        if (sum == G) break;
        __builtin_amdgcn_s_sleep(1);
        if ((++sp & 255u) == 0u) { if (xb_ld(&bar[XB_TMO])) break; if (sp > XB_SPIN_CAP) { atomicAdd(&bar[XB_TMO], 1u); break; } }
    }
    nloc = mine > 0u ? mine : 1u; nx = cnt > 0u ? cnt : 1u;
}
DI void xcd_barrier(const XcdBarrier& b) {
    asm volatile("s_waitcnt vmcnt(0)" ::: "memory");
    __syncthreads();
    if (threadIdx.x == 0) {
        unsigned* bar = b.bar;
        __builtin_amdgcn_s_waitcnt(0);
        unsigned nloc = b.st[0], nx = b.st[1];
        if (nloc == 0u) { xcd_barrier_complete(bar, b.x, nloc, nx); b.st[0] = nloc; b.st[1] = nx; }
        const unsigned old = xb_add(&bar[XB_XSUB(b.x)], 1u);
        const unsigned gen = old / nloc;
        if (old + 1u == (gen + 1u) * nloc) {
            __builtin_amdgcn_fence(__ATOMIC_RELEASE, "agent");
            asm volatile("s_waitcnt vmcnt(0)" ::: "memory");
            const unsigned og = xb_add(&bar[XB_TOP], 1u);
            const unsigned tg = og / nx;
            if (og + 1u == (tg + 1u) * nx) xb_add(&bar[XB_TOPGEN], 1u);
            else XB_SPIN(xb_ld(&bar[XB_TOPGEN]) == tg, bar);
            __builtin_amdgcn_fence(__ATOMIC_ACQUIRE, "agent");
            xb_add(&bar[XB_XGEN(b.x)], 1u);
            asm volatile("s_waitcnt vmcnt(0)" ::: "memory");
        } else {
            XB_SPIN(xb_ld(&bar[XB_XGEN(b.x)]) == gen, bar);
            __builtin_amdgcn_fence(__ATOMIC_ACQUIRE, "agent");
            asm volatile("s_waitcnt vmcnt(0)" ::: "memory");
        }
    }
    __syncthreads();
}

namespace pg8 {
#define PG8_LAS __attribute__((address_space(3)))
typedef unsigned short bf16_t;
typedef short bf16x8 __attribute__((ext_vector_type(8)));
typedef float f32x4 __attribute__((ext_vector_type(4)));
typedef unsigned u32x4 __attribute__((ext_vector_type(4)));
constexpr int BM = 256, BK = 64, HALF = 128, HTB = HALF * BK * 2  , STAGE_BYTES = 8 * HTB, NXCD = 8, WGM = 8;

__host__ __device__ __forceinline__ int lds_byte(int r, int c) { const int st = (r >> 4) * 2 + (c >> 5), rr = r & 15, cc = c & 31, ob = rr * 64 + cc * 2; return st * 1024 + (ob ^ (((ob >> 9) & 1) << 5)); }
__host__ __device__ __forceinline__ void stage_rc(int b, int& R, int& C) { const int st = b / 1024, sb = b % 1024, swz = sb ^ (((sb >> 9) & 1) << 5); R = (st >> 1) * 16 + swz / 64; C = (st & 1) * 32 + (swz % 64) / 2; }
__host__ __device__ __forceinline__ int perm32(int rho) { const int n = rho >> 4, i = rho & 15; return 8 * (i >> 2) + 4 * n + (i & 3); }

struct Unit { int pm, pn; };
struct Gemm { const bf16_t* A; const bf16_t* Bt; int M, N, K; };

struct StaticOrder {
    int nM, nN, nwg, G, c;
    __host__ __device__ void init(int M, int N, int G_, int c_) { nM = M / BM; nN = N / BM; nwg = nM * nN; G = G_; c = c_; }
    __host__ __device__ bool next(int i, Unit& u) const {
        const long L = (long)i * G + c; if (L >= nwg) return false;
        int wgid = (int)L; { const int q = nwg / NXCD, r = nwg % NXCD, xcd = wgid % NXCD, off = wgid / NXCD; wgid = (xcd < r ? xcd * (q + 1) : r * (q + 1) + (xcd - r) * q) + off; }
        const int nig = WGM * nN, gid = wgid / nig, fm = gid * WGM, gsz = (nM - fm) < WGM ? (nM - fm) : WGM;
        u.pm = fm + ((wgid % nig) % gsz); u.pn = (wgid % nig) / gsz; return true;
    }
    __device__ __forceinline__ void a_ready(const Unit&) const {}
    __device__ __forceinline__ void done(const Unit&) const {}
};
template <class Epi, class Sched, bool ALIGN_EPI = false, bool SP2 = false>
__device__ __forceinline__ void gemm_phase(PG8_LAS unsigned char* lds, const Gemm g, const Sched& S, const Epi& E) {
    int tid = threadIdx.x; asm volatile("" : "+v"(tid));
    const int wid = __builtin_amdgcn_readfirstlane(tid >> 6), lane = tid & 63, wr = wid >> 2, wc = wid & 3, fr = lane & 15, fq = lane >> 4;
    const int K = g.K, nt = K / BK;
    unsigned voffA[2], voffB[2];
#pragma unroll
    for (int i = 0; i < 2; ++i) { int R, C; stage_rc(tid * 16 + i * 8192, R, C); const int Rb = Epi::PERM ? ((R & ~31) + perm32(R & 31)) : R;
        voffA[i] = (unsigned)(R * K + C) * 2u; voffB[i] = (unsigned)(Rb * K + C) * 2u; }
    const size_t kstep = (size_t)(BK * 2);
    const size_t hstep = (size_t)HALF * K * 2;
    const size_t tstep = 2 * hstep;
    const unsigned ldsw = (unsigned)wid * 1024u;
    const int aoff = lds_byte(wr * 64 + fr, fq * 8), boff = lds_byte(wc * 32 + fr, fq * 8);
#define PG8_SA(b, h) (((b) * 2 + (h)) * HTB)
#define PG8_SB(b, h) ((4 + (b) * 2 + (h)) * HTB)
#define PG8_STAGE(bufoff, gbase, voff) do { _Pragma("unroll") for (int _i = 0; _i < 2; ++_i) \
        __builtin_amdgcn_global_load_lds((const unsigned*)((const char*)(gbase) + (voff)[_i]), (PG8_LAS unsigned*)(lds + (bufoff) + ldsw + _i * 8192), 16, 0, 0); } while (0)
#define PG8_LDA(dst, b, h) do { _Pragma("unroll") for (int m = 0; m < 4; ++m) _Pragma("unroll") for (int k = 0; k < 2; ++k) dst[m][k] = *(const PG8_LAS bf16x8*)(lds + PG8_SA(b, h) + aoff + m * 2048 + k * 1024); } while (0)
#define PG8_LDB(dst, b, h) do { _Pragma("unroll") for (int n = 0; n < 2; ++n) _Pragma("unroll") for (int k = 0; k < 2; ++k) dst[n][k] = *(const PG8_LAS bf16x8*)(lds + PG8_SB(b, h) + boff + n * 2048 + k * 1024); } while (0)
#define PG8_MMA(ai, bj, At, Bt) do { __builtin_amdgcn_s_setprio(1); _Pragma("unroll") for (int m = 0; m < 4; ++m) _Pragma("unroll") for (int n = 0; n < 2; ++n) _Pragma("unroll") for (int k = 0; k < 2; ++k) \
        acc[ai][bj][m][n] = __builtin_amdgcn_mfma_f32_16x16x32_bf16(Bt[n][k], At[m][k], acc[ai][bj][m][n], 0, 0, 0); __builtin_amdgcn_s_setprio(0); } while (0)
#define PG8_WAIT_V(n) asm volatile("s_waitcnt vmcnt(" #n ")" ::: "memory")
#define PG8_WAIT_L(n) asm volatile("s_waitcnt lgkmcnt(" #n ")" ::: "memory")
#define PG8_BAR __builtin_amdgcn_s_barrier()
#define PG8_SCHED __builtin_amdgcn_sched_barrier(0)
    Unit cur, nxt; int ui = 0;
    if (!S.next(0, cur)) return;
    f32x4 acc[2][2][4][2];
#pragma unroll
    for (int a = 0; a < 2; ++a)
#pragma unroll
        for (int b = 0; b < 2; ++b)
#pragma unroll
            for (int m = 0; m < 4; ++m)
#pragma unroll
                for (int n = 0; n < 2; ++n) acc[a][b][m][n] = (f32x4){0.f, 0.f, 0.f, 0.f};
    bf16x8 At[4][2], B0[2][2], B1[2][2];
    const char* cA = (const char*)g.A + (size_t)cur.pm * tstep; const char* cB = (const char*)g.Bt + (size_t)cur.pn * tstep;
    S.a_ready(cur);
    if constexpr (SP2) {
        PG8_STAGE(PG8_SB(0, 0), cB, voffB); PG8_STAGE(PG8_SB(0, 1), cB + hstep, voffB); PG8_STAGE(PG8_SA(0, 0), cA, voffA); PG8_STAGE(PG8_SA(0, 1), cA + hstep, voffA);
        if (wr == 1) PG8_BAR;
        PG8_WAIT_V(2); PG8_BAR;
        PG8_STAGE(PG8_SB(1, 0), cB + kstep, voffB); PG8_STAGE(PG8_SA(1, 0), cA + kstep, voffA); PG8_STAGE(PG8_SB(1, 1), cB + hstep + kstep, voffB);
        PG8_WAIT_V(6); PG8_BAR;
    } else {
        PG8_STAGE(PG8_SB(0, 0), cB, voffB); PG8_STAGE(PG8_SA(0, 0), cA, voffA); PG8_STAGE(PG8_SB(0, 1), cB + hstep, voffB); PG8_STAGE(PG8_SA(0, 1), cA + hstep, voffA);
        if (wr == 1) PG8_BAR;
        PG8_WAIT_V(4); PG8_BAR;
        PG8_STAGE(PG8_SB(1, 0), cB + kstep, voffB); PG8_STAGE(PG8_SA(1, 0), cA + kstep, voffA); PG8_STAGE(PG8_SB(1, 1), cB + hstep + kstep, voffB);
        PG8_WAIT_V(6); PG8_BAR;
    }
    for (;;) {
        const bool has_next = S.next(ui + 1, nxt);
        const char* nA = has_next ? (const char*)g.A + (size_t)nxt.pm * tstep : cA; const char* nB = has_next ? (const char*)g.Bt + (size_t)nxt.pn * tstep : cB;
        for (int t = 0; t < nt; t += 2) {
            const bool last = (t == nt - 2);
            const char* a1 = cA + (size_t)(t + 1) * kstep;
            const char* a2 = last ? nA : cA + (size_t)(t + 2) * kstep; const char* b2 = last ? nB : cB + (size_t)(t + 2) * kstep;
            const char* a3 = a2 + kstep; const char* b3 = b2 + kstep;
            if (last && has_next) S.a_ready(nxt);
            if constexpr (SP2) {
            PG8_LDB(B0, 0, 0); PG8_LDB(B1, 0, 1); PG8_SCHED; PG8_LDA(At, 0, 0); PG8_STAGE(PG8_SA(1, 1), a1 + hstep, voffA);
            PG8_WAIT_V(8); PG8_WAIT_L(0); PG8_BAR; PG8_MMA(0, 0, At, B0); PG8_MMA(0, 1, At, B1); PG8_BAR; PG8_SCHED;
            PG8_LDA(At, 0, 1); PG8_STAGE(PG8_SB(0, 0), b2, voffB); PG8_STAGE(PG8_SB(0, 1), b2 + hstep, voffB); PG8_STAGE(PG8_SA(0, 0), a2, voffA);
            PG8_WAIT_V(8); PG8_WAIT_L(0); PG8_BAR; PG8_MMA(1, 0, At, B0); PG8_MMA(1, 1, At, B1); PG8_BAR; PG8_SCHED;
            PG8_LDB(B0, 1, 0); PG8_LDB(B1, 1, 1); PG8_SCHED; PG8_LDA(At, 1, 0); PG8_STAGE(PG8_SA(0, 1), a2 + hstep, voffA);
            PG8_WAIT_V(8); PG8_WAIT_L(0); PG8_BAR; PG8_MMA(0, 0, At, B0); PG8_MMA(0, 1, At, B1); PG8_BAR; PG8_SCHED;
            PG8_LDA(At, 1, 1); PG8_STAGE(PG8_SB(1, 0), b3, voffB); PG8_STAGE(PG8_SB(1, 1), b3 + hstep, voffB); PG8_STAGE(PG8_SA(1, 0), a3, voffA);
            PG8_WAIT_V(8); PG8_WAIT_L(0); PG8_BAR; PG8_MMA(1, 0, At, B0); PG8_MMA(1, 1, At, B1); PG8_BAR; PG8_SCHED;
            } else {
            PG8_LDB(B0, 0, 0); PG8_SCHED; PG8_LDA(At, 0, 0); PG8_STAGE(PG8_SA(1, 1), a1 + hstep, voffA);
            PG8_WAIT_L(8); PG8_BAR; PG8_WAIT_L(0); PG8_MMA(0, 0, At, B0); PG8_BAR; PG8_SCHED;
            PG8_LDB(B1, 0, 1); PG8_STAGE(PG8_SB(0, 0), b2, voffB);
            PG8_BAR; PG8_WAIT_L(0); PG8_MMA(0, 1, At, B1); PG8_BAR;
            PG8_LDA(At, 0, 1); PG8_STAGE(PG8_SA(0, 0), a2, voffA);
            PG8_BAR; PG8_WAIT_L(0); PG8_MMA(1, 0, At, B0); PG8_BAR; PG8_SCHED;
            PG8_STAGE(PG8_SB(0, 1), b2 + hstep, voffB);
            PG8_WAIT_V(6); PG8_BAR; PG8_MMA(1, 1, At, B1); PG8_BAR;
            PG8_LDB(B0, 1, 0); PG8_SCHED; PG8_LDA(At, 1, 0); PG8_STAGE(PG8_SA(0, 1), a2 + hstep, voffA);
            PG8_WAIT_L(8); PG8_BAR; PG8_WAIT_L(0); PG8_MMA(0, 0, At, B0); PG8_BAR; PG8_SCHED;
            PG8_LDB(B1, 1, 1); PG8_STAGE(PG8_SB(1, 0), b3, voffB);
            PG8_BAR; PG8_WAIT_L(0); PG8_MMA(0, 1, At, B1); PG8_BAR;
            PG8_LDA(At, 1, 1); PG8_STAGE(PG8_SA(1, 0), a3, voffA);
            PG8_BAR; PG8_WAIT_L(0); PG8_MMA(1, 0, At, B0); PG8_BAR; PG8_SCHED;
            PG8_STAGE(PG8_SB(1, 1), b3 + hstep, voffB);
            PG8_WAIT_V(6); PG8_BAR; PG8_MMA(1, 1, At, B1); PG8_BAR;
            }
        }
        if constexpr (ALIGN_EPI) { if (wr == 0) PG8_BAR; }
        if constexpr (!Epi::AFTER_DRAIN) { E(acc, cur, wr, wc, fr, fq); S.done(cur); }
        if (!has_next) break;
#pragma unroll
        for (int a = 0; a < 2; ++a)
#pragma unroll
            for (int b = 0; b < 2; ++b)
#pragma unroll
                for (int m = 0; m < 4; ++m)
#pragma unroll
                    for (int n = 0; n < 2; ++n) acc[a][b][m][n] = (f32x4){0.f, 0.f, 0.f, 0.f};
        cur = nxt; cA = nA; cB = nB; ++ui;
        if constexpr (ALIGN_EPI) { if (wr == 1) PG8_BAR; }
    }
    PG8_WAIT_V(0);
    if constexpr (!ALIGN_EPI) { if (wr == 0) PG8_BAR; }
    PG8_BAR;
    if constexpr (Epi::AFTER_DRAIN) { E.fused(acc, cur, wr, wc, fr, fq, lds, wid, lane); S.done(cur); }
#undef PG8_SA
#undef PG8_SB
#undef PG8_STAGE
#undef PG8_LDA
#undef PG8_LDB
#undef PG8_MMA
#undef PG8_WAIT_V
#undef PG8_WAIT_L
#undef PG8_BAR
#undef PG8_SCHED
}
}

DI unsigned* gate_ptr(const char* ws, int l, int k) { return (unsigned*)(ws + OFF_CTR) + 1024 + (l * 2 + k) * 320; }
DI void gate_arrive(unsigned* g, int tid, unsigned xcc, unsigned nloc) {
    asm volatile("s_waitcnt vmcnt(0)" ::: "memory");
    __syncthreads();
    if (tid == 0) {
        const unsigned old = xb_add(g + 16 * (xcc + 1), 1u);
        if (old + 1u == nloc) {
            __builtin_amdgcn_fence(__ATOMIC_RELEASE, "agent");
            asm volatile("s_waitcnt vmcnt(0)" ::: "memory");
            (void)xb_add(g, nloc);
        }
    }
}
DI void gate_wait(unsigned* g, unsigned target, int tid) {
    if (tid == 0) {
        unsigned sp = 0;
        while (xb_ld(g) < target) { __builtin_amdgcn_s_sleep(2); if (++sp > (1u << 24)) break; }
        __builtin_amdgcn_fence(__ATOMIC_ACQUIRE, "agent");
        asm volatile("s_waitcnt vmcnt(0)" ::: "memory");
    }
    __syncthreads();
}

DI int inproj_srccol(int np) {
    const int pn = np >> 8, c = np & 255, bj = c >> 7, wc = (c & 127) >> 5, j = c & 31;
    const int nlog = pn * 256 + 64 * wc + 32 * bj + j;
    return nlog < 2048 ? nlog : nlog + 8;
}
template <int MODE>
DI void transpose_tile(const float* src, int lds_, int k0, const float* gk, const float* gn, short* dst, int ldd, int n0, float* tile, int tid) {
    __syncthreads();
    {
        const int n4 = (tid & 15) * 4, kq = tid >> 4;
        const int col = (MODE == 0) ? inproj_srccol(n0 + n4) : (n0 + n4);
        f32x4 gnv = {1.f, 1.f, 1.f, 1.f};
        if (gn) gnv = *(const f32x4*)(gn + n0 + n4);
#pragma unroll
        for (int i = 0; i < 2; ++i) {
            const int k = i * 32 + kq;
            f32x4 v = *(const f32x4*)(src + (size_t)(k0 + k) * lds_ + col);
            const float g = gk ? gk[k0 + k] : 1.f;
            v = v * gnv * g;
            tile[k * 65 + n4] = v[0]; tile[k * 65 + n4 + 1] = v[1]; tile[k * 65 + n4 + 2] = v[2]; tile[k * 65 + n4 + 3] = v[3];
        }
    }
    __syncthreads();
    {
        const int n = tid >> 3, k8 = (tid & 7) * 8;
        u32x4 o;
#pragma unroll
        for (int q = 0; q < 4; ++q) o[q] = pk2(tile[(k8 + 2 * q) * 65 + n], tile[(k8 + 2 * q + 1) * 65 + n]);
        *(u32x4*)(dst + (size_t)(n0 + n) * ldd + k0 + k8) = o;
    }
}

DI void convert_layer(const Params& p, int l, char* lds, int tid, int vb, int nb) {
    float* tile = (float*)lds;
    short* wtin = (short*)(p.ws + OFF_WTIN) + (size_t)l * NP * DM; short* wtout = (short*)(p.ws + OFF_WTOUT) + (size_t)l * DM * DM;
    short* wtpool = (short*)(p.ws + OFF_WTPOOL) + (size_t)l * 4 * 4096; short* wtff = (short*)(p.ws + OFF_WTFF) + (size_t)l * 16 * DM;
    for (int e = vb * NT + tid; e < 16 * DM; e += nb * NT) {
        const int f = e >> 10, k = e & (DM - 1);
        const float v = (f < 8) ? p.w_in[((size_t)l * DM + k) * DIN + 2048 + f] * p.norm_g[l * DM + k] : 0.f;
        wtff[e] = (short)(pk2(v, 0.f) & 0xffffu);
    }
    if (vb == 0 && tid < 64) {
        float gq = fabsf(p.qg[l * 64 + tid]), gk = fabsf(p.kg[l * 64 + tid]);
#pragma unroll
        for (int d = 32; d >= 1; d >>= 1) { gq = fmaxf(gq, __shfl_xor(gq, d)); gk = fmaxf(gk, __shfl_xor(gk, d)); }
        if (tid == 0) ((float*)(p.ws + OFF_CTR))[3968 + l] = 8.f * gq * gk * LOG2E * 1.02f + 0.25f;
    }
    constexpr int U_IN = 16 * 56, U_OUT = 16 * 16, U_POOL = 4;
    for (int u = vb; u < U_IN + U_OUT + U_POOL; u += nb) {
        if (u < U_IN) {
            const int ntile = u / 16, kt = u % 16;
            transpose_tile<0>(p.w_in + (size_t)l * DM * DIN, DIN, kt * 64, p.norm_g + l * DM, nullptr, wtin, DM, ntile * 64, tile, tid);
        } else if (u < U_IN + U_OUT) {
            const int v = u - U_IN; const int ntile = v / 16, kt = v % 16;
            transpose_tile<1>(p.w_out + (size_t)l * DM * DM, DM, kt * 64, nullptr, nullptr, wtout, DM, ntile * 64, tile, tid);
        } else {
            const int g = u - U_IN - U_OUT;
            transpose_tile<1>(p.w_pool + (size_t)(l * 4 + g) * 4096, 64, 0, nullptr, p.pool_scale + l * 256 + g * 64, wtpool + (size_t)g * 4096, 64, 0, tile, tid);
        }
    }
    __syncthreads();
}

DI void phase_prologue(const Params& p, char* lds, int tid) {
    if (blockIdx.x == 0 && tid < 16) ((unsigned*)(p.ws + OFF_CTR))[tid] = 0u;
    convert_layer(p, 0, lds, tid, (int)blockIdx.x, (int)gridDim.x);
    short* xb = (short*)(p.ws + OFF_XB); float* ssq = (float*)(p.ws + OFF_SSQ);
    const int lane = tid & 63, w = tid >> 6;
    for (int row = blockIdx.x * 8 + w; row < T; row += gridDim.x * 8) {
        const float* xr = p.x + (size_t)row * DM;
        float ss = 0.f;
#pragma unroll
        for (int j = 0; j < 4; ++j) {
            const f32x4 v = *(const f32x4*)(xr + j * 256 + lane * 4);
            ss += v[0] * v[0] + v[1] * v[1] + v[2] * v[2] + v[3] * v[3];
            u32x2 o = {pk2(v[0], v[1]), pk2(v[2], v[3])};
            *(u32x2*)(xb + (size_t)row * DM + j * 256 + lane * 4) = o;
        }
#pragma unroll
        for (int d = 32; d >= 1; d >>= 1) ss += __shfl_xor(ss, d);
        if (lane < 16) ssq[(size_t)row * 16 + lane] = (lane == 0) ? ss : 0.f;
    }
}

typedef float pf32x4 __attribute__((ext_vector_type(4)));
DI float row_rstd(const float* ssq, int row, int fq) {
    const f32x4 v = *(const f32x4*)(ssq + (size_t)row * 16 + 4 * fq);
    float s = (v[0] + v[1]) + (v[2] + v[3]);
    s += __shfl_xor(s, 16); s += __shfl_xor(s, 32);
    return __builtin_amdgcn_rsqf(s * (1.f / 1024.f) + EPS);
}
struct EpiIn {
    static constexpr bool PERM = true, AFTER_DRAIN = false;
    char* ws; const float* qg; const float* kg;
    DI void operator()(const pg8::f32x4 (&acc)[2][2][4][2], const pg8::Unit& u, int wr, int wc, int fr, int fq) const {
        asm volatile("" : "+v"(fr), "+v"(fq));
        const int pn = u.pn;
        const float* ssq = (const float*)(ws + OFF_SSQ);
        float rstdv[2][4];
        {
            f32x4 sv[2][4];
#pragma unroll
            for (int ai = 0; ai < 2; ++ai)
#pragma unroll
                for (int m = 0; m < 4; ++m) sv[ai][m] = *(const f32x4*)(ssq + (size_t)(u.pm * 256 + ai * 128 + wr * 64 + m * 16 + fr) * 16 + 4 * fq);
            PIN8(sv);
#pragma unroll
            for (int ai = 0; ai < 2; ++ai)
#pragma unroll
                for (int m = 0; m < 4; ++m) {
                    float sx = (sv[ai][m][0] + sv[ai][m][1]) + (sv[ai][m][2] + sv[ai][m][3]);
                    sx += __shfl_xor(sx, 16); sx += __shfl_xor(sx, 32);
                    rstdv[ai][m] = __builtin_amdgcn_rsqf(sx * (1.f / 1024.f) + EPS);
                }
        }
#pragma unroll
        for (int ai = 0; ai < 2; ++ai)
#pragma unroll
            for (int m = 0; m < 4; ++m) {
                const int row = u.pm * 256 + ai * 128 + wr * 64 + m * 16 + fr;
                const float rstd = rstdv[ai][m];
                const int b = row >> 12, s = row & 4095;
                if (pn < 4) {
                    float ss = 0.f;
#pragma unroll
                    for (int bj = 0; bj < 2; ++bj)
#pragma unroll
                        for (int n = 0; n < 2; ++n)
#pragma unroll
                            for (int c = 0; c < 4; ++c) { const float v = acc[ai][bj][m][n][c]; ss += v * v; }
                    ss += __shfl_xor(ss, 16); ss += __shfl_xor(ss, 32);
                    ss *= rstd * rstd;
                    const float rn = __builtin_amdgcn_rsqf(ss * (1.f / 64.f) + EPS) * rstd * (pn < 2 ? 0.125f * LOG2E : 1.f);
                    const float* gv = (pn < 2) ? qg : kg;
                    short* dst = (short*)(ws + (pn < 2 ? OFF_QF : OFF_KF)) + ((size_t)(b * 8 + (pn & 1) * 4 + wc) * S + s) * 64;
#pragma unroll
                    for (int bj = 0; bj < 2; ++bj) {
                        const int d = 32 * bj + 8 * fq;
                        const f32x4 g0 = *(const f32x4*)(gv + d), g1 = *(const f32x4*)(gv + d + 4);
                        const f32x4 v0 = acc[ai][bj][m][0] * (g0 * rn), v1 = acc[ai][bj][m][1] * (g1 * rn);
                        store8(dst + d, v0, v1);
                    }
                } else if (pn == 4 || pn == 5 || pn == 12) {
                    short* base = (pn == 12) ? ((short*)(ws + OFF_SVT) + ((size_t)(b * 4 + wc) * 64) * S)
                                             : ((short*)(ws + OFF_VTF) + ((size_t)(b * 8 + (pn - 4) * 4 + wc) * 64) * S);
#pragma unroll
                    for (int bj = 0; bj < 2; ++bj)
#pragma unroll
                        for (int n = 0; n < 2; ++n)
#pragma unroll
                            for (int c = 0; c < 4; c += 2) {
                                const int d = 32 * bj + 8 * fq + 4 * n + c;
                                const unsigned pk = pk2(acc[ai][bj][m][n][c] * rstd, acc[ai][bj][m][n][c + 1] * rstd);
                                base[(size_t)d * S + s] = (short)(pk & 0xffffu);
                                base[(size_t)(d + 1) * S + s] = (short)(pk >> 16);
                            }
                } else {
                    short* dst; bool dosilu = false; float sc = rstd;
                    if (pn == 6 || pn == 7) { dst = (short*)(ws + OFF_MIX) + (size_t)row * DM + (pn - 6) * 256 + wc * 64; }
                    else if (pn == 8) { dst = (short*)(ws + OFF_PX) + (size_t)row * 256 + wc * 64; }
                    else if (pn == 9) { dst = (short*)(ws + OFF_MIX) + (size_t)row * DM + 512 + wc * 64; }
                    else if (pn == 10) { dst = (short*)(ws + OFF_SQ) + ((size_t)(b * 4 + wc) * S + s) * 64; sc = rstd * 0.125f * LOG2E; }
                    else if (pn == 11) { dst = (short*)(ws + OFF_SK) + ((size_t)(b * 4 + wc) * S + s) * 64; }
                    else { dst = (short*)(ws + OFF_MIX) + (size_t)row * DM + 768 + wc * 64; }
#pragma unroll
                    for (int bj = 0; bj < 2; ++bj) {
                        f32x4 v0 = acc[ai][bj][m][0] * sc, v1 = acc[ai][bj][m][1] * sc;
                        if (dosilu) {
#pragma unroll
                            for (int c = 0; c < 4; ++c) { v0[c] = silu_f(v0[c]); v1[c] = silu_f(v1[c]); }
                        }
                        store8(dst + 32 * bj + 8 * fq, v0, v1);
                    }
                }
            }
    }
};
struct EpiOut {
    static constexpr bool PERM = true, AFTER_DRAIN = false;
    const float* res32; float* out; short* xb; float* ssq; int first; int last;
    DI void operator()(const pg8::f32x4 (&acc)[2][2][4][2], const pg8::Unit& u, int wr, int wc, int fr, int fq) const {
        asm volatile("" : "+v"(fr), "+v"(fq));
#pragma unroll
        for (int ai = 0; ai < 2; ++ai) {
            u32x4 rb[2][4];
            if (!first) {
#pragma unroll
                for (int m = 0; m < 4; ++m)
#pragma unroll
                    for (int bj = 0; bj < 2; ++bj)
                        rb[bj][m] = *(const u32x4*)(xb + (size_t)(u.pm * 256 + ai * 128 + wr * 64 + m * 16 + fr) * DM + u.pn * 256 + bj * 128 + wc * 32 + fq * 8);
                PIN8(rb);
            }
#pragma unroll
            for (int m = 0; m < 4; ++m) {
                const int row = u.pm * 256 + ai * 128 + wr * 64 + m * 16 + fr;
                float ss = 0.f;
#pragma unroll
                for (int bj = 0; bj < 2; ++bj) {
                    const size_t off = (size_t)row * DM + u.pn * 256 + bj * 128 + wc * 32 + fq * 8;
                    f32x4 r0, r1;
                    if (first) { r0 = *(const f32x4*)(res32 + off); r1 = *(const f32x4*)(res32 + off + 4); }
                    else {
                        const u32x4 rv = rb[bj][m];
                        r0 = (f32x4){bf_lo(rv[0]), bf_hi(rv[0]), bf_lo(rv[1]), bf_hi(rv[1])}; r1 = (f32x4){bf_lo(rv[2]), bf_hi(rv[2]), bf_lo(rv[3]), bf_hi(rv[3])};
                    }
                    const f32x4 o0 = r0 + acc[ai][bj][m][0], o1 = r1 + acc[ai][bj][m][1];
                    if (last) { *(f32x4*)(out + off) = o0; *(f32x4*)(out + off + 4) = o1; }
                    else {
                        ss += (o0[0] * o0[0] + o0[1] * o0[1]) + (o0[2] * o0[2] + o0[3] * o0[3]) + (o1[0] * o1[0] + o1[1] * o1[1]) + (o1[2] * o1[2] + o1[3] * o1[3]);
                        store8(xb + off, o0, o1);
                    }
                }
                if (!last) { ss += __shfl_xor(ss, 16); ss += __shfl_xor(ss, 32); if (fq == 0) ssq[(size_t)row * 16 + u.pn * 4 + wc] = ss; }
            }
        }
    }
};

DI void ff_job(const Params& p, int l, int tb, int tid) {
    const int lane = tid & 63, w = tid >> 6, fr = lane & 15, fq = lane >> 4;
    const int tok = tb * 128 + w * 16 + fr;
    const short* wff = (const short*)(p.ws + OFF_WTFF) + (size_t)l * 16 * DM + fr * DM + fq * 8;
    const short* xr = (const short*)(p.ws + OFF_XB) + (size_t)tok * DM + fq * 8;
    pg8::f32x4 acc = {0.f, 0.f, 0.f, 0.f};
#pragma unroll 16
    for (int ks = 0; ks < 32; ++ks) {
        const bf16x8 a = *(const bf16x8*)(wff + ks * 32), bq = *(const bf16x8*)(xr + ks * 32);
        acc = __builtin_amdgcn_mfma_f32_16x16x32_bf16(a, bq, acc, 0, 0, 0);
    }
    const float* sp = (const float*)(p.ws + OFF_SSQ) + (size_t)tok * 16;
    const f32x4 s0 = *(const f32x4*)sp, s1 = *(const f32x4*)(sp + 4), s2 = *(const f32x4*)(sp + 8), s3 = *(const f32x4*)(sp + 12);
    const float ssum = ((s0[0] + s0[1]) + (s0[2] + s0[3])) + ((s1[0] + s1[1]) + (s1[2] + s1[3])) + ((s2[0] + s2[1]) + (s2[2] + s2[3])) + ((s3[0] + s3[1]) + (s3[2] + s3[3]));
    const float rstd = __builtin_amdgcn_rsqf(ssum * (1.f / 1024.f) + EPS);
    if (fq < 2) {
        const int b = tok >> 12, s = tok & 4095;
        float* LOGF = (float*)(p.ws + OFF_LOGF);
#pragma unroll
        for (int i = 0; i < 4; ++i) {
            const int f = 4 * fq + i;
            const float v = acc[i] * rstd + p.b_f[l * 8 + f];
            LOGF[(size_t)(b * 8 + f) * S + s] = fminf(v, 0.f) - log1pf(expf(-fabsf(v)));
        }
    }
}

struct InSchedA {
    pg8::StaticOrder s;
    __device__ bool next(int i, pg8::Unit& u) const { if (!s.next(i, u)) return false; u.pn = (u.pn < 9) ? u.pn : u.pn + 1; return true; }
    DI void a_ready(const pg8::Unit&) const {}
    DI void done(const pg8::Unit&) const {}
};
struct InSchedB {
    pg8::StaticOrder s;
    __device__ bool next(int i, pg8::Unit& u) const { if (!s.next(i, u)) return false; u.pn = u.pn ? 13 : 9; return true; }
    DI void a_ready(const pg8::Unit&) const {}
    DI void done(const pg8::Unit&) const {}
};
DI void phase_inproj(const Params& p, int l, char* lds, int tid, unsigned xcc, unsigned nloc) {
    const int G = gridDim.x, c = (int)blockIdx.x;
    for (int tb = G - 1 - c; tb < 128; tb += G) ff_job(p, l, tb, tid);
    pg8::Gemm g{(const pg8::bf16_t*)(p.ws + OFF_XB), (const pg8::bf16_t*)(p.ws + OFF_WTIN) + (size_t)l * NP * DM, T, NP, DM};
    EpiIn E{p.ws, p.qg + l * 64, p.kg + l * 64};
    { InSchedA Sa; Sa.s.init(T, 12 * 256, G, c); pg8::gemm_phase<EpiIn, InSchedA, true, true>((PG8_LAS unsigned char*)lds, g, Sa, E); }
    gate_arrive(gate_ptr(p.ws, l, 0), tid, xcc, nloc);
    { InSchedB Sb; Sb.s.init(T, 2 * 256, G, c); pg8::gemm_phase<EpiIn, InSchedB, true, true>((PG8_LAS unsigned char*)lds, g, Sb, E); }
    gate_arrive(gate_ptr(p.ws, l, 1), tid, xcc, nloc);
}
DI void phase_outproj(const Params& p, int l, char* lds, int tid) {
    const int G = gridDim.x;
    pg8::Gemm g{(const pg8::bf16_t*)(p.ws + OFF_MIX), (const pg8::bf16_t*)(p.ws + OFF_WTOUT) + (size_t)l * DM * DM, T, DM, DM};
    pg8::StaticOrder So; So.init(T, DM, G, (int)blockIdx.x);
    EpiOut E{p.x, p.out, (short*)(p.ws + OFF_XB), (float*)(p.ws + OFF_SSQ), (l == 0) ? 1 : 0, (l + 1 == NL) ? 1 : 0};
    pg8::gemm_phase<EpiOut, pg8::StaticOrder, true, true>((PG8_LAS unsigned char*)lds, g, So, E);
}

constexpr int STG_BYTES = 16384, RING_OFF = 16384;
DI void glds16(const void* gsrc, unsigned lds_dst) {
    unsigned keep;
    asm volatile("s_mov_b32 %0, m0\n\ts_mov_b32 m0, %2\n\ts_nop 0\n\tglobal_load_lds_dwordx4 %1, off\n\ts_mov_b32 m0, %0" : "=&s"(keep) : "v"(gsrc), "s"(lds_dst) : "memory");
}
DI void kv_dma(const short* Kb, const short* Vtb, int j, char* stage, int tid) {
    const int w = tid >> 6, row = tid >> 3, ch = (tid & 7) ^ ((row >> 1) & 7);
    const unsigned dst = (unsigned)__builtin_amdgcn_readfirstlane((int)(unsigned)(size_t)(LAS char*)stage + w * 1024);
    glds16(Kb + (size_t)(64 * j + row) * 64 + ch * 8, dst);
    glds16(Vtb + (size_t)row * S + 64 * j + ch * 8, dst + 8192u);
}
DI void kv_wait_bar(int rem) {
    if (rem >= 2) asm volatile("s_waitcnt vmcnt(4)\n\ts_waitcnt lgkmcnt(0)\n\ts_barrier" ::: "memory");
    else if (rem == 1) asm volatile("s_waitcnt vmcnt(2)\n\ts_waitcnt lgkmcnt(0)\n\ts_barrier" ::: "memory");
    else asm volatile("s_waitcnt vmcnt(0)\n\ts_waitcnt lgkmcnt(0)\n\ts_barrier" ::: "memory");
}

DI void fox_qk(const char* kb, const float* cp, const bf16x8 (&qf)[4], float bt, int krow, int hi, f32x16 (&sacc)[2]) {
    bf16x8 kf[2][4];
#pragma unroll
    for (int sub = 0; sub < 2; ++sub)
#pragma unroll
        for (int kk = 0; kk < 4; ++kk) kf[sub][kk] = *(const bf16x8*)(kb + swz(32 * sub + krow, 2 * kk + hi));
    f32x4 cv[2][4];
#pragma unroll
    for (int sub = 0; sub < 2; ++sub)
#pragma unroll
        for (int q4 = 0; q4 < 4; ++q4) cv[sub][q4] = *(const f32x4*)(cp + 32 * sub + 4 * q4);
    PIN8(kf); PIN8(cv);
#pragma unroll
    for (int sub = 0; sub < 2; ++sub)
#pragma unroll
        for (int q4 = 0; q4 < 4; ++q4) {
            sacc[sub][4 * q4] = bt - cv[sub][q4][0]; sacc[sub][4 * q4 + 1] = bt - cv[sub][q4][1]; sacc[sub][4 * q4 + 2] = bt - cv[sub][q4][2]; sacc[sub][4 * q4 + 3] = bt - cv[sub][q4][3];
        }
    __builtin_amdgcn_s_setprio(1);
#pragma unroll
    for (int kk = 0; kk < 4; ++kk)
#pragma unroll
        for (int sub = 0; sub < 2; ++sub) sacc[sub] = MFMA32(kf[sub][kk], qf[kk], sacc[sub]);
    __builtin_amdgcn_s_setprio(0);
}
template <bool MASK>
DI void fox_sm(const f32x16 (&sacc)[2], int lim, float& lsum, bf16x8 (&pf)[2][2]) {
#pragma unroll
    for (int sub = 0; sub < 2; ++sub) {
        float pr[16];
#pragma unroll
        for (int i = 0; i < 16; ++i) {
            float pv = fexp2(sacc[sub][i]);
            if (MASK) { if (i + 32 * sub > lim) pv = 0.f; }
            pr[i] = pv;
        }
        pf[sub][0] = pack8(pr[0], pr[1], pr[2], pr[3], pr[4], pr[5], pr[6], pr[7]);
        pf[sub][1] = pack8(pr[8], pr[9], pr[10], pr[11], pr[12], pr[13], pr[14], pr[15]);
    }
}
DI void fox_pv(const char* vb, int r, int hi, const bf16x8 (&pf)[2][2], f32x16 (&oacc)[2], f32x16& lacc) {
    bf16x8 vf[2][4];
#pragma unroll
    for (int mi = 0; mi < 2; ++mi)
#pragma unroll
        for (int c = 0; c < 4; ++c) vf[mi][c] = *(const bf16x8*)(vb + swz(32 * mi + r, 4 * (c >> 1) + 2 * hi + (c & 1)));
    PIN8(vf);
    const u32x4 onesu = {0x3f803f80u, 0x3f803f80u, 0x3f803f80u, 0x3f803f80u};
    const bf16x8 ones = __builtin_bit_cast(bf16x8, onesu);
    __builtin_amdgcn_s_setprio(1);
#pragma unroll
    for (int c = 0; c < 4; ++c) {
#pragma unroll
        for (int mi = 0; mi < 2; ++mi) oacc[mi] = MFMA32(vf[mi][c], pf[c >> 1][c & 1], oacc[mi]);
        lacc = MFMA32(ones, pf[c >> 1][c & 1], lacc);
    }
    __builtin_amdgcn_s_setprio(0);
}
DI void fox_unit(const Params& p, int l, int bh, int qb, char* lds, int tid) {
    const int lane = tid & 63, w = tid >> 6, r = lane & 31, hi = lane >> 5;
    float* cs = (float*)lds; char* ring = lds + RING_OFF; float* misc = (float*)(lds + LDS_MISC);
    const short* Kb = (const short*)(p.ws + OFF_KF) + (size_t)bh * S * 64;
    const short* Vtb = (const short*)(p.ws + OFF_VTF) + (size_t)bh * 64 * S;
    const int kmax = (qb + 1) * 256, jmax = 4 * qb + 3;
    kv_dma(Kb, Vtb, jmax, ring, tid);
    const float M2 = ((const float*)(p.ws + OFF_CTR))[3968 + l];
    const int qrow = qb * 256 + w * 32 + r;
    bf16x8 qf[4];
    {
        const short* qp = (const short*)(p.ws + OFF_QF) + ((size_t)bh * S + qrow) * 64 + hi * 8;
#pragma unroll
        for (int kk = 0; kk < 4; ++kk) qf[kk] = *(const bf16x8*)(qp + kk * 16);
    }
    {
        const float* lf = (const float*)(p.ws + OFF_LOGF) + (size_t)bh * S + tid * 8;
        float v[8];
        if (tid * 8 < kmax) {
#pragma unroll
            for (int q = 0; q < 2; ++q) { const f32x4 t4 = *(const f32x4*)(lf + 4 * q); v[4 * q] = t4[0]; v[4 * q + 1] = t4[1]; v[4 * q + 2] = t4[2]; v[4 * q + 3] = t4[3]; }
        } else {
#pragma unroll
            for (int q = 0; q < 8; ++q) v[q] = 0.f;
        }
#pragma unroll
        for (int q = 1; q < 8; ++q) v[q] += v[q - 1];
        const float tot = v[7];
        float sc = tot;
#pragma unroll
        for (int d = 1; d < 64; d <<= 1) { const float t2 = __shfl_up(sc, d); if (lane >= d) sc += t2; }
        if (lane == 63) misc[w] = sc;
        __syncthreads();
        float off = sc - tot;
        for (int j = 0; j < w; ++j) off += misc[j];
#pragma unroll
        for (int q = 0; q < 8; ++q) cs[tid * 8 + q] = (off + v[q]) * LOG2E;
    }
    __syncthreads();
    int jlo = 0;
#if FOX_SKIP
    {
        const float cq = cs[qb * 256];
        const bool c = (lane <= jmax) && (cq - cs[64 * lane + 63] < -(152.f + 2.f * M2));
        const unsigned long long mask = __ballot(c);
        jlo = mask ? (64 - __builtin_clzll(mask)) : 0;
        if (jlo > jmax) jlo = jmax;
    }
#endif
    int jloww = jlo;
#if FOX_SKIP
    {
        const float cqw = cs[qb * 256 + w * 32];
        const bool c2 = (lane <= jmax) && (cqw - cs[64 * lane + 63] < -(152.f + 2.f * M2));
        const unsigned long long mask2 = __ballot(c2);
        jloww = mask2 ? (64 - __builtin_clzll(mask2)) : 0;
        const int jdiag = (qb * 256 + w * 32) >> 6;
        if (jloww > jdiag) jloww = jdiag;
        if (jloww < jlo) jloww = jlo;
    }
#endif
    float bt = cs[qrow] - M2;
    asm volatile("" : "+v"(qf[0]), "+v"(qf[1]), "+v"(qf[2]), "+v"(qf[3]), "+v"(bt));
    asm volatile("s_waitcnt vmcnt(0)" ::: "memory");
#pragma unroll
    for (int t = 1; t < 4; ++t) if (jmax - t >= jlo) kv_dma(Kb, Vtb, jmax - t, ring + t * STG_BYTES, tid);
    f32x16 oacc[2];
#pragma unroll
    for (int mi = 0; mi < 2; ++mi)
#pragma unroll
        for (int i = 0; i < 16; ++i) oacc[mi][i] = 0.f;
    float lsum = 0.f;
    f32x16 lacc;
#pragma unroll
    for (int i = 0; i < 16; ++i) lacc[i] = 0.f;
    const int qmin = qb * 256 + w * 32;
    const int krow = 16 * ((r >> 2) & 1) + 4 * (r >> 3) + (r & 3);
    const int ntl = jmax - jlo + 1;
    const int nch = (ntl + 1) >> 1;
    for (int c = 0; c < nch; ++c) {
        const int nnext = (2 * c + 3 < ntl) ? 2 : ((2 * c + 2 < ntl) ? 1 : 0);
        kv_wait_bar(nnext);
        {
            const int t0 = 2 * c + 4;
            if (t0 < ntl) kv_dma(Kb, Vtb, jmax - t0, ring + (t0 % 6) * STG_BYTES, tid);
            if (t0 + 1 < ntl) kv_dma(Kb, Vtb, jmax - t0 - 1, ring + ((t0 + 1) % 6) * STG_BYTES, tid);
        }
#pragma unroll
        for (int h2 = 0; h2 < 2; ++h2) {
            const int t = 2 * c + h2;
            const int key0 = 64 * (jmax - t);
            if (t < ntl && key0 <= qmin + 31 && (jmax - t) >= jloww) {
                const char* stg = ring + (t % 6) * STG_BYTES;
                f32x16 sc[2];
                fox_qk(stg, cs + key0 + 16 * hi, qf, bt, krow, hi, sc);
                bf16x8 pf[2][2];
                if (key0 + 63 > qmin) fox_sm<true>(sc, qrow - key0 - 16 * hi, lsum, pf); else fox_sm<false>(sc, 0, lsum, pf);
                fox_pv(stg + 8192, r, hi, pf, oacc, lacc);
            }
        }
    }
    lsum = lacc[0];
    const float inv = __builtin_amdgcn_rcpf(lsum);
    const int b = bh >> 3, h = bh & 7;
    short* mp = (short*)(p.ws + OFF_MIX) + (size_t)(b * S + qrow) * DM + h * 64;
#pragma unroll
    for (int mi = 0; mi < 2; ++mi)
#pragma unroll
        for (int g = 0; g < 4; ++g) {
            const int d = 32 * mi + 8 * g + 4 * hi;
            const u32x2 gv = *(const u32x2*)(mp + d);
            store4(mp + d, oacc[mi][4 * g] * inv * silu_f(bf_lo(gv[0])), oacc[mi][4 * g + 1] * inv * silu_f(bf_hi(gv[0])), oacc[mi][4 * g + 2] * inv * silu_f(bf_lo(gv[1])), oacc[mi][4 * g + 3] * inv * silu_f(bf_hi(gv[1])));
        }
}

template <bool MASK>
DI void sb_tile(const char* kb, const bf16x8 (&qf)[4], int krow, int r, int hi, int lim, f32x16 (&oacc)[2], float& Rc) {
    const char* vb = kb + 8192;
    bf16x8 kf[2][4];
#pragma unroll
    for (int sub = 0; sub < 2; ++sub)
#pragma unroll
        for (int kk = 0; kk < 4; ++kk) kf[sub][kk] = *(const bf16x8*)(kb + swz(32 * sub + krow, 2 * kk + hi));
    PIN8(kf);
    f32x16 z[2];
#pragma unroll
    for (int sub = 0; sub < 2; ++sub) {
#pragma unroll
        for (int i = 0; i < 16; ++i) z[sub][i] = 0.f;
#pragma unroll
        for (int kk = 0; kk < 4; ++kk) z[sub] = MFMA32(kf[sub][kk], qf[kk], z[sub]);
    }
    bf16x8 vf[2][4];
#pragma unroll
    for (int mi = 0; mi < 2; ++mi)
#pragma unroll
        for (int c = 0; c < 4; ++c) vf[mi][c] = *(const bf16x8*)(vb + swz(32 * mi + r, 4 * (c >> 1) + 2 * hi + (c & 1)));
    PIN8(vf);
    float Tt[2];
#pragma unroll
    for (int sub = 1; sub >= 0; --sub) {
        float run = 0.f;
#pragma unroll
        for (int i = 15; i >= 0; --i) {
            const float zz = z[sub][i];
            const float e = fexp2(-fabsf(zz));
            float sp = fmaxf(zz, 0.f) + flog2(1.f + e);
            float val = zz + (run - sp);
            if (MASK) { if (i + 32 * sub >= lim) { sp = 0.f; val = -INFINITY; } }
            z[sub][i] = val;
            run -= sp;
        }
        Tt[sub] = run;
    }
    const float T1p = __shfl_xor(Tt[1], 32), T0p = __shfl_xor(Tt[0], 32);
    const float sum1 = Tt[1] + T1p;
    float off[2];
    off[1] = Rc + (hi == 0 ? T1p : 0.f);
    off[0] = Rc + sum1 + (hi == 0 ? T0p : 0.f);
    Rc = Rc + sum1 + Tt[0] + T0p;
    bf16x8 pf[2][2];
#pragma unroll
    for (int sub = 0; sub < 2; ++sub) {
        float pr[16];
#pragma unroll
        for (int i = 0; i < 16; ++i) pr[i] = fexp2(z[sub][i] + off[sub]);
        pf[sub][0] = pack8(pr[0], pr[1], pr[2], pr[3], pr[4], pr[5], pr[6], pr[7]);
        pf[sub][1] = pack8(pr[8], pr[9], pr[10], pr[11], pr[12], pr[13], pr[14], pr[15]);
    }
#pragma unroll
    for (int c = 0; c < 4; ++c)
#pragma unroll
        for (int mi = 0; mi < 2; ++mi) oacc[mi] = MFMA32(vf[mi][c], pf[c >> 1][c & 1], oacc[mi]);
}

DI void sb_unit(const Params& p, int bh, int qb, char* lds, int tid) {
    const int lane = tid & 63, w = tid >> 6, r = lane & 31, hi = lane >> 5;
    char* ring = lds + RING_OFF; volatile int* flags = (volatile int*)(lds + LDS_MISC + 256);
    const short* Kb = (const short*)(p.ws + OFF_SK) + (size_t)bh * S * 64;
    const short* Vtb = (const short*)(p.ws + OFF_SVT) + (size_t)bh * 64 * S;
    const int jmax = 4 * qb + 3;
    const int qrow = qb * 256 + w * 32 + r;
    const int nwin = (jmax + 1 < 8) ? (jmax + 1) : 8;
#pragma unroll
    for (int t = 0; t < 8; ++t) if (t < nwin) kv_dma(Kb, Vtb, jmax - t, lds + t * STG_BYTES, tid);
    bf16x8 qf[4];
    {
        const short* qp = (const short*)(p.ws + OFF_SQ) + ((size_t)bh * S + qrow) * 64 + hi * 8;
#pragma unroll
        for (int kk = 0; kk < 4; ++kk) qf[kk] = *(const bf16x8*)(qp + kk * 16);
    }
    asm volatile("" : "+v"(qf[0]), "+v"(qf[1]), "+v"(qf[2]), "+v"(qf[3]));
    f32x16 oacc[2];
#pragma unroll
    for (int mi = 0; mi < 2; ++mi)
#pragma unroll
        for (int i = 0; i < 16; ++i) oacc[mi][i] = 0.f;
    float Rc = 0.f;
    const int qmin = qb * 256 + w * 32;
    const int krow = 16 * ((r >> 2) & 1) + 4 * (r >> 3) + (r & 3);
    asm volatile("s_waitcnt vmcnt(0)\n\ts_barrier" ::: "memory");
    const int tw = 3 - (w >> 1);
    bool wdone = false;
    for (int t = 0; t < nwin; ++t) {
        if (t >= tw && !wdone) {
            const int key0 = 64 * (jmax - t);
            const char* kb = lds + t * STG_BYTES;
            if (key0 + 63 >= qmin) sb_tile<true>(kb, qf, krow, r, hi, qrow - key0 - 16 * hi, oacc, Rc);
            else sb_tile<false>(kb, qf, krow, r, hi, 0, oacc, Rc);
            wdone = __all(Rc < -152.f);
        }
    }
    if (lane == 0) flags[16 + w] = wdone ? 1 : 0;
    __syncthreads();
    int ndw = 0;
#pragma unroll
    for (int q = 0; q < 8; ++q) ndw += flags[16 + q];
    const int jstart = jmax - 8;
    if (ndw < 8 && jstart >= 0) {
#pragma unroll
        for (int t = 0; t < 3; ++t) if (jstart - t >= 0) kv_dma(Kb, Vtb, jstart - t, ring + t * STG_BYTES, tid);
        int it = 0;
        for (int j = jstart; j >= 0; --j, ++it) {
            const int cur = it & 1;
            kv_wait_bar(j);
            if (j >= 3) kv_dma(Kb, Vtb, j - 3, ring + ((it + 3) & 3) * STG_BYTES, tid);
            if (it > 0) {
                int nd = 0;
#pragma unroll
                for (int q = 0; q < 8; ++q) nd += flags[(cur ^ 1) * 8 + q];
                if (nd == 8) break;
            }
            if (!wdone) {
                sb_tile<false>(ring + (it & 3) * STG_BYTES, qf, krow, r, hi, 0, oacc, Rc);
                wdone = __all(Rc < -152.f);
            }
            if (lane == 0) flags[cur * 8 + w] = wdone ? 1 : 0;
        }
        asm volatile("s_waitcnt vmcnt(0)" ::: "memory");
    }
    const int b = bh >> 2, h = bh & 3;
    short* mp = (short*)(p.ws + OFF_MIX) + (size_t)(b * S + qrow) * DM + 768 + h * 64;
#pragma unroll
    for (int mi = 0; mi < 2; ++mi)
#pragma unroll
        for (int g = 0; g < 4; ++g) {
            const int d = 32 * mi + 8 * g + 4 * hi;
            const u32x2 gv = *(const u32x2*)(mp + d);
            store4(mp + d, oacc[mi][4 * g] * silu_f(bf_lo(gv[0])), oacc[mi][4 * g + 1] * silu_f(bf_hi(gv[0])), oacc[mi][4 * g + 2] * silu_f(bf_lo(gv[1])), oacc[mi][4 * g + 3] * silu_f(bf_hi(gv[1])));
        }
    __syncthreads();
}

template <int G>
DI void pool_group(const Params& p, int l, int tok0, char* lds, int tid) {
    const int lane = tid & 63, w = tid >> 6, r = lane & 31, hi = lane >> 5;
    constexpr int wlen = 2 << G;
    const int tl = w * 32 + r, token = tok0 + tl, s = token & 4095;
    const short* px = (const short*)(p.ws + OFF_PX);
    const short* wp = (const short*)(p.ws + OFF_WTPOOL) + (size_t)(l * 4 + G) * 4096;
    short* mp = (short*)(p.ws + OFF_MIX) + (size_t)token * DM + 512 + G * 64;
    __syncthreads();
#pragma unroll
    for (int i = 0; i < 5; ++i) {
        const int c = tid + NT * i;
        if (c < 271 * 8) {
            const int row = c >> 3, ch = c & 7, tok = tok0 - 15 + row;
            u32x4 v = {0u, 0u, 0u, 0u};
            if (tok >= 0) v = *(const u32x4*)(px + (size_t)tok * 256 + G * 64 + ch * 8);
            *(u32x4*)(lds + swz(row, ch)) = v;
        }
    }
    __syncthreads();
    const int cnt = (s + 1 < wlen) ? (s + 1) : wlen;
    const float icnt = 1.f / (float)cnt;
    f32x16 oacc[2];
#pragma unroll
    for (int mi = 0; mi < 2; ++mi)
#pragma unroll
        for (int i = 0; i < 16; ++i) oacc[mi][i] = 0.f;
#pragma unroll 1
    for (int kk = 0; kk < 4; ++kk) {
        float sum[8], x0[8];
        {
            const u32x4 v = *(const u32x4*)(lds + swz(tl + 15, 2 * kk + hi));
#pragma unroll
            for (int q = 0; q < 4; ++q) { x0[2 * q] = bf_lo(v[q]); x0[2 * q + 1] = bf_hi(v[q]); sum[2 * q] = x0[2 * q]; sum[2 * q + 1] = x0[2 * q + 1]; }
        }
#pragma unroll
        for (int jj = 1; jj < wlen; ++jj) {
            const u32x4 v = *(const u32x4*)(lds + swz(tl + 15 - jj, 2 * kk + hi));
            const bool ok = jj < cnt;
#pragma unroll
            for (int q = 0; q < 4; ++q) { sum[2 * q] += ok ? bf_lo(v[q]) : 0.f; sum[2 * q + 1] += ok ? bf_hi(v[q]) : 0.f; }
        }
        const bf16x8 pfr = pack8(sum[0] * icnt - x0[0], sum[1] * icnt - x0[1], sum[2] * icnt - x0[2], sum[3] * icnt - x0[3],
                                 sum[4] * icnt - x0[4], sum[5] * icnt - x0[5], sum[6] * icnt - x0[6], sum[7] * icnt - x0[7]);
#pragma unroll
        for (int mi = 0; mi < 2; ++mi) {
            const bf16x8 wf = *(const bf16x8*)(wp + (32 * mi + r) * 64 + kk * 16 + hi * 8);
            oacc[mi] = MFMA32(wf, pfr, oacc[mi]);
        }
    }
#pragma unroll
    for (int mi = 0; mi < 2; ++mi)
#pragma unroll
        for (int gg = 0; gg < 4; ++gg) {
            const int d = 32 * mi + 8 * gg + 4 * hi;
            const u32x2 gv = *(const u32x2*)(mp + d);
            store4(mp + d, oacc[mi][4 * gg] * silu_f(bf_lo(gv[0])), oacc[mi][4 * gg + 1] * silu_f(bf_hi(gv[0])), oacc[mi][4 * gg + 2] * silu_f(bf_lo(gv[1])), oacc[mi][4 * gg + 3] * silu_f(bf_hi(gv[1])));
        }
}
DI void pool_unit(const Params& p, int l, int tt, char* lds, int tid) {
    pool_group<0>(p, l, tt * 256, lds, tid); pool_group<1>(p, l, tt * 256, lds, tid);
    pool_group<2>(p, l, tt * 256, lds, tid); pool_group<3>(p, l, tt * 256, lds, tid);
    __syncthreads();
}

DI void phase_mixers(const Params& p, int l, char* lds, int tid) {
    unsigned* ctr = (unsigned*)(p.ws + OFF_CTR) + l;
    volatile int* su = (volatile int*)(lds + LDS_MISC + 512);
    constexpr int U_FOX = 32 * 16, U_SB = 16 * 16, U_POOL = 64, U_CONV = 72;
    const int nconv = (l + 1 < NL) ? U_CONV : 0;
    bool g1 = false, g2 = false;
    for (;;) {
        __syncthreads();
        asm volatile("" : "+v"(tid));
        if (tid == 0) su[0] = (int)__hip_atomic_fetch_add(ctr, 1u, __ATOMIC_RELAXED, __HIP_MEMORY_SCOPE_AGENT);
        __syncthreads();
        int u = su[0];
        if (u >= U_FOX + U_SB + U_POOL + nconv) break;
        if (u >= U_FOX + U_SB + U_POOL) { convert_layer(p, l + 1, lds, tid, u - (U_FOX + U_SB + U_POOL), U_CONV); continue; }
        constexpr int FSPLIT = 5, U_F1 = 32 * (16 - FSPLIT);
        if (u >= U_F1 && u < U_FOX + U_SB) u = (u < U_F1 + U_SB) ? (u - U_F1 + U_FOX) : (u - U_SB);
        if (u < U_FOX) { if (!g1) { gate_wait(gate_ptr(p.ws, l, 0), gridDim.x, tid); g1 = true; } }
        else if (!g2) { gate_wait(gate_ptr(p.ws, l, 1), gridDim.x, tid); g1 = true; g2 = true; }
        if (u < U_FOX) fox_unit(p, l, u & 31, 15 - (u >> 5), lds, tid);
        else if (u < U_FOX + U_SB) { const int v = u - U_FOX; sb_unit(p, v & 15, 15 - (v >> 4), lds, tid); }
        else pool_unit(p, l, u - U_FOX - U_SB, lds, tid);
    }
}

__global__ void __launch_bounds__(NT, 2) mega(Params p, int ph_lo, int ph_hi) {
    extern __shared__ __attribute__((aligned(16))) char lds[];
    const int tid0 = threadIdx.x;
    if (p.use_cg) cg::this_grid().sync();
    XcdBarrier bar;
    volatile LAS unsigned* xbw = (volatile LAS unsigned*)(lds + LDS_MISC + 1024);
    if (ph_hi - ph_lo > 1) {
        if (tid0 < 4) xbw[tid0] = 0u;
        __syncthreads();
        bar = xcd_barrier_post((unsigned*)(p.ws + OFF_BAR), xbw);
    }
    for (int ph = ph_lo; ph < ph_hi; ++ph) {
        int tid = tid0; asm volatile("" : "+v"(tid));
        if (ph == 0) phase_prologue(p, lds, tid);
        else {
            const int l = (ph - 1) / 3, k = (ph - 1) % 3;
            if (k == 0) phase_inproj(p, l, lds, tid, bar.x, xbw[0]);
            else if (k == 1) phase_mixers(p, l, lds, tid);
            else phase_outproj(p, l, lds, tid);
        }
        if (ph + 1 < ph_hi && !(ph > 0 && (ph - 1) % 3 == 0)) {
            unsigned long long bp = (unsigned long long)(p.ws + OFF_BAR); asm volatile("" : "+s"(bp));
            bar.bar = (unsigned*)bp;
            xcd_barrier(bar);
        }
    }
}

extern "C" void kernel_launch(void* const* d_in, const int* in_sizes, int n_in, void* d_out, int out_size, void* d_ws, size_t ws_size, hipStream_t stream) {
    Params p{};
    p.x = (const float*)d_in[0]; p.norm_g = (const float*)d_in[1]; p.w_in = (const float*)d_in[2]; p.b_f = (const float*)d_in[3];
    p.qg = (const float*)d_in[4]; p.kg = (const float*)d_in[5]; p.w_pool = (const float*)d_in[6]; p.pool_scale = (const float*)d_in[7];
    p.w_out = (const float*)d_in[8]; p.out = (float*)d_out; p.ws = (char*)d_ws; p.use_cg = 0; p.pad = 0;
    if (ws_size < WS_NEED) { fprintf(stderr, "workspace too small: %zu < %zu\n", ws_size, WS_NEED); return; }
    static bool attr_set = false;
    if (!attr_set) {
        if (hipFuncSetAttribute((const void*)mega, hipFuncAttributeMaxDynamicSharedMemorySize, LDS_TOTAL) != hipSuccess) fprintf(stderr, "hipFuncSetAttribute failed\n");
        attr_set = true;
    }
    const int grid = 256;
    constexpr int NPH = 1 + 3 * NL;
    (void)hipMemsetAsync(d_ws, 0, 32768, stream);
    int lo = 0, hi = NPH;
    void* args[] = {&p, &lo, &hi};
    hipError_t e = hipLaunchCooperativeKernel((const void*)mega, dim3(grid), dim3(NT), args, LDS_TOTAL, stream);
    if (e != hipSuccess) fprintf(stderr, "cooperative launch failed: %s\n", hipGetErrorString(e));
}
```

```cpp
#include <hip/hip_runtime.h>
#include <hip/hip_cooperative_groups.h>
#include <cstdint>
#include <cstdio>
namespace cg = cooperative_groups;

#ifndef SB_EARLY_EXIT
#define SB_EARLY_EXIT 1
#endif
#ifndef FOX_SKIP
#define FOX_SKIP 1
#endif
#define DI __device__ __forceinline__
#define LAS __attribute__((address_space(3)))
typedef short bf16x8 __attribute__((ext_vector_type(8)));
typedef float f32x16 __attribute__((ext_vector_type(16)));
typedef float f32x4 __attribute__((ext_vector_type(4)));
typedef float f32x2 __attribute__((ext_vector_type(2)));
typedef unsigned u32x4 __attribute__((ext_vector_type(4)));
typedef unsigned u32x2 __attribute__((ext_vector_type(2)));
typedef __bf16 bf2_t __attribute__((ext_vector_type(2)));
#define MFMA32(a, b, c) __builtin_amdgcn_mfma_f32_32x32x16_bf16((a), (b), (c), 0, 0, 0)
#define PIN8(a) asm volatile("" : "+v"(a[0][0]), "+v"(a[0][1]), "+v"(a[0][2]), "+v"(a[0][3]), "+v"(a[1][0]), "+v"(a[1][1]), "+v"(a[1][2]), "+v"(a[1][3]))

constexpr int NB = 4, S = 4096, DM = 1024, NL = 4, T = NB * S, NT = 512;
constexpr int DIN = 3592, NP = 3584;
constexpr float LOG2E = 1.4426950408889634f;
constexpr float EPS = 1e-6f;

constexpr size_t OFF_BAR = 0;
constexpr size_t OFF_CTR = 16384;
constexpr size_t OFF_WTIN = 32768;
constexpr size_t OFF_WTOUT = OFF_WTIN + (size_t)NL * NP * DM * 2;
constexpr size_t OFF_WTPOOL = OFF_WTOUT + (size_t)NL * DM * DM * 2;
constexpr size_t OFF_WTFF = OFF_WTPOOL + (size_t)NL * 4 * 64 * 64 * 2;
constexpr size_t OFF_XB = OFF_WTFF + (size_t)NL * 16 * DM * 2;
constexpr size_t OFF_SSQ = OFF_XB + (size_t)T * DM * 2;
constexpr size_t OFF_QF = OFF_SSQ + (size_t)T * 16 * 4;
constexpr size_t OFF_KF = OFF_QF + (size_t)T * 512 * 2;
constexpr size_t OFF_VTF = OFF_KF + (size_t)T * 512 * 2;
constexpr size_t OFF_PX = OFF_VTF + (size_t)T * 512 * 2;
constexpr size_t OFF_SQ = OFF_PX + (size_t)T * 256 * 2;
constexpr size_t OFF_SK = OFF_SQ + (size_t)T * 256 * 2;
constexpr size_t OFF_SVT = OFF_SK + (size_t)T * 256 * 2;
constexpr size_t OFF_LOGF = OFF_SVT + (size_t)T * 256 * 2;
constexpr size_t OFF_MIX = OFF_LOGF + (size_t)NB * 8 * S * 4;
constexpr size_t WS_NEED = OFF_MIX + (size_t)T * DM * 2;

struct Params {
    const float *x, *norm_g, *w_in, *b_f, *qg, *kg, *w_pool, *pool_scale, *w_out;
    float* out; char* ws; int use_cg; int pad;
};

constexpr int LDS_MISC = 131072;
constexpr int LDS_TOTAL = LDS_MISC + 2048;

DI unsigned pk2(float a, float b) { f32x2 v = {a, b}; bf2_t r = __builtin_convertvector(v, bf2_t); return __builtin_bit_cast(unsigned, r); }
DI float bf_lo(unsigned u) { return __uint_as_float(u << 16); }
DI float bf_hi(unsigned u) { return __uint_as_float(u & 0xffff0000u); }
DI float fexp2(float x) { return __builtin_amdgcn_exp2f(x); }
DI float flog2(float x) { return __builtin_amdgcn_logf(x); }
DI float silu_f(float v) { return v * __builtin_amdgcn_rcpf(1.f + fexp2(-v * LOG2E)); }
DI int swz(int row, int chunk) { return row * 128 + ((chunk ^ ((row >> 1) & 7)) << 4); }
DI bf16x8 pack8(float a0, float a1, float a2, float a3, float a4, float a5, float a6, float a7) {
    u32x4 u = {pk2(a0, a1), pk2(a2, a3), pk2(a4, a5), pk2(a6, a7)}; return __builtin_bit_cast(bf16x8, u);
}
DI void store4(short* p, float a, float b, float c, float d) { u32x2 o = {pk2(a, b), pk2(c, d)}; *(u32x2*)p = o; }
DI void store8(short* p, const f32x4& a, const f32x4& b) { u32x4 o = {pk2(a[0], a[1]), pk2(a[2], a[3]), pk2(b[0], b[1]), pk2(b[2], b[3])}; *(u32x4*)p = o; }
#define XB_TMO      128
#define XB_XCNT(j)  (256  + 64 * (j))
#define XB_XSUB(j)  (1280 + 64 * (j))
#define XB_XGEN(j)  (2304 + 64 * (j))
#define XB_TOP      3328
#define XB_TOPGEN   3392
#define XCD_BAR_WORDS 3456
#define XB_SPIN_CAP (1u << 22)
DI unsigned xb_ld(unsigned* p)              { return __hip_atomic_load(p, __ATOMIC_RELAXED, __HIP_MEMORY_SCOPE_AGENT); }
DI unsigned xb_add(unsigned* p, unsigned v) { return __hip_atomic_fetch_add(p, v, __ATOMIC_RELAXED, __HIP_MEMORY_SCOPE_AGENT); }
DI unsigned xb_xcc_id() { return (unsigned)__builtin_amdgcn_readfirstlane((int)(__builtin_amdgcn_s_getreg((3 << 11) | 20) & 0xFu)); }
#define XB_SPIN(cond, bar) do { unsigned _sp = 0; while (cond) { __builtin_amdgcn_s_sleep(1); \
    if ((++_sp & 255u) == 0u) { if (xb_ld(&(bar)[XB_TMO])) break; if (_sp > XB_SPIN_CAP) { atomicAdd(&(bar)[XB_TMO], 1u); break; } } } } while (0)
struct XcdBarrier { unsigned* bar; unsigned x; volatile LAS unsigned* st; };
DI XcdBarrier xcd_barrier_post(unsigned* bar, volatile LAS unsigned* st) {
    XcdBarrier b; b.bar = bar; b.x = xb_xcc_id(); b.st = st;
    if (threadIdx.x == 0) (void)xb_add(&bar[XB_XCNT(b.x)], 1u);
    return b;
}
DI void xcd_barrier_complete(unsigned* bar, unsigned x, unsigned& nloc, unsigned& nx) {
    const unsigned G = gridDim.x * gridDim.y * gridDim.z;
    unsigned sum, cnt, mine, sp = 0u;
    for (;;) {
        sum = 0u; cnt = 0u; mine = 0u;
#pragma unroll
        for (unsigned j = 0; j < 16; ++j) { const unsigned c = xb_ld(&bar[XB_XCNT(j)]); sum += c; cnt += (c > 0u) ? 1u : 0u; mine = (j == x) ? c : mine; }
        if (sum == G) break;
        __builtin_amdgcn_s_sleep(1);
        if ((++sp & 255u) == 0u) { if (xb_ld(&bar[XB_TMO])) break; if (sp > XB_SPIN_CAP) { atomicAdd(&bar[XB_TMO], 1u); break; } }
    }
    nloc = mine > 0u ? mine : 1u; nx = cnt > 0u ? cnt : 1u;
}
DI void xcd_barrier(const XcdBarrier& b) {
    asm volatile("s_waitcnt vmcnt(0)" ::: "memory");
    __syncthreads();
    if (threadIdx.x == 0) {
        unsigned* bar = b.bar;
        __builtin_amdgcn_s_waitcnt(0);
        unsigned nloc = b.st[0], nx = b.st[1];
        if (nloc == 0u) { xcd_barrier_complete(bar, b.x, nloc, nx); b.st[0] = nloc; b.st[1] = nx; }
        const unsigned old = xb_add(&bar[XB_XSUB(b.x)], 1u);
        const unsigned gen = old / nloc;
        if (old + 1u == (gen + 1u) * nloc) {
            __builtin_amdgcn_fence(__ATOMIC_RELEASE, "agent");
            asm volatile("s_waitcnt vmcnt(0)" ::: "memory");
            const unsigned og = xb_add(&bar[XB_TOP], 1u);
            const unsigned tg = og / nx;
            if (og + 1u == (tg + 1u) * nx) xb_add(&bar[XB_TOPGEN], 1u);
            else XB_SPIN(xb_ld(&bar[XB_TOPGEN]) == tg, bar);
            __builtin_amdgcn_fence(__ATOMIC_ACQUIRE, "agent");
            xb_add(&bar[XB_XGEN(b.x)], 1u);
            asm volatile("s_waitcnt vmcnt(0)" ::: "memory");
        } else {
            XB_SPIN(xb_ld(&bar[XB_XGEN(b.x)]) == gen, bar);
            __builtin_amdgcn_fence(__ATOMIC_ACQUIRE, "agent");
            asm volatile("s_waitcnt vmcnt(0)" ::: "memory");
        }
    }
    __syncthreads();
}

namespace pg8 {
#define PG8_LAS __attribute__((address_space(3)))
typedef unsigned short bf16_t;
typedef short bf16x8 __attribute__((ext_vector_type(8)));
typedef float f32x4 __attribute__((ext_vector_type(4)));
typedef unsigned u32x4 __attribute__((ext_vector_type(4)));
constexpr int BM = 256, BK = 64, HALF = 128, HTB = HALF * BK * 2  , STAGE_BYTES = 8 * HTB, NXCD = 8, WGM = 8;

__host__ __device__ __forceinline__ int lds_byte(int r, int c) { const int st = (r >> 4) * 2 + (c >> 5), rr = r & 15, cc = c & 31, ob = rr * 64 + cc * 2; return st * 1024 + (ob ^ (((ob >> 9) & 1) << 5)); }
__host__ __device__ __forceinline__ void stage_rc(int b, int& R, int& C) { const int st = b / 1024, sb = b % 1024, swz = sb ^ (((sb >> 9) & 1) << 5); R = (st >> 1) * 16 + swz / 64; C = (st & 1) * 32 + (swz % 64) / 2; }
__host__ __device__ __forceinline__ int perm32(int rho) { const int n = rho >> 4, i = rho & 15; return 8 * (i >> 2) + 4 * n + (i & 3); }

struct Unit { int pm, pn; };
struct Gemm { const bf16_t* A; const bf16_t* Bt; int M, N, K; };

struct StaticOrder {
    int nM, nN, nwg, G, c;
    __host__ __device__ void init(int M, int N, int G_, int c_) { nM = M / BM; nN = N / BM; nwg = nM * nN; G = G_; c = c_; }
    __host__ __device__ bool next(int i, Unit& u) const {
        const long L = (long)i * G + c; if (L >= nwg) return false;
        int wgid = (int)L; { const int q = nwg / NXCD, r = nwg % NXCD, xcd = wgid % NXCD, off = wgid / NXCD; wgid = (xcd < r ? xcd * (q + 1) : r * (q + 1) + (xcd - r) * q) + off; }
        const int nig = WGM * nN, gid = wgid / nig, fm = gid * WGM, gsz = (nM - fm) < WGM ? (nM - fm) : WGM;
        u.pm = fm + ((wgid % nig) % gsz); u.pn = (wgid % nig) / gsz; return true;
    }
    __device__ __forceinline__ void a_ready(const Unit&) const {}
    __device__ __forceinline__ void done(const Unit&) const {}
};
template <class Epi, class Sched, bool ALIGN_EPI = false, bool SP2 = false>
__device__ __forceinline__ void gemm_phase(PG8_LAS unsigned char* lds, const Gemm g, const Sched& S, const Epi& E) {
    int tid = threadIdx.x; asm volatile("" : "+v"(tid));
    const int wid = __builtin_amdgcn_readfirstlane(tid >> 6), lane = tid & 63, wr = wid >> 2, wc = wid & 3, fr = lane & 15, fq = lane >> 4;
    const int K = g.K, nt = K / BK;
    unsigned voffA[2], voffB[2];
#pragma unroll
    for (int i = 0; i < 2; ++i) { int R, C; stage_rc(tid * 16 + i * 8192, R, C); const int Rb = Epi::PERM ? ((R & ~31) + perm32(R & 31)) : R;
        voffA[i] = (unsigned)(R * K + C) * 2u; voffB[i] = (unsigned)(Rb * K + C) * 2u; }
    const size_t kstep = (size_t)(BK * 2);
    const size_t hstep = (size_t)HALF * K * 2;
    const size_t tstep = 2 * hstep;
    const unsigned ldsw = (unsigned)wid * 1024u;
    const int aoff = lds_byte(wr * 64 + fr, fq * 8), boff = lds_byte(wc * 32 + fr, fq * 8);
#define PG8_SA(b, h) (((b) * 2 + (h)) * HTB)
#define PG8_SB(b, h) ((4 + (b) * 2 + (h)) * HTB)
#define PG8_STAGE(bufoff, gbase, voff) do { _Pragma("unroll") for (int _i = 0; _i < 2; ++_i) \
        __builtin_amdgcn_global_load_lds((const unsigned*)((const char*)(gbase) + (voff)[_i]), (PG8_LAS unsigned*)(lds + (bufoff) + ldsw + _i * 8192), 16, 0, 0); } while (0)
#define PG8_LDA(dst, b, h) do { _Pragma("unroll") for (int m = 0; m < 4; ++m) _Pragma("unroll") for (int k = 0; k < 2; ++k) dst[m][k] = *(const PG8_LAS bf16x8*)(lds + PG8_SA(b, h) + aoff + m * 2048 + k * 1024); } while (0)
#define PG8_LDB(dst, b, h) do { _Pragma("unroll") for (int n = 0; n < 2; ++n) _Pragma("unroll") for (int k = 0; k < 2; ++k) dst[n][k] = *(const PG8_LAS bf16x8*)(lds + PG8_SB(b, h) + boff + n * 2048 + k * 1024); } while (0)
#define PG8_MMA(ai, bj, At, Bt) do { __builtin_amdgcn_s_setprio(1); _Pragma("unroll") for (int m = 0; m < 4; ++m) _Pragma("unroll") for (int n = 0; n < 2; ++n) _Pragma("unroll") for (int k = 0; k < 2; ++k) \
        acc[ai][bj][m][n] = __builtin_amdgcn_mfma_f32_16x16x32_bf16(Bt[n][k], At[m][k], acc[ai][bj][m][n], 0, 0, 0); __builtin_amdgcn_s_setprio(0); } while (0)
#define PG8_WAIT_V(n) asm volatile("s_waitcnt vmcnt(" #n ")" ::: "memory")
#define PG8_WAIT_L(n) asm volatile("s_waitcnt lgkmcnt(" #n ")" ::: "memory")
#define PG8_BAR __builtin_amdgcn_s_barrier()
#define PG8_SCHED __builtin_amdgcn_sched_barrier(0)
    Unit cur, nxt; int ui = 0;
    if (!S.next(0, cur)) return;
    f32x4 acc[2][2][4][2];
#pragma unroll
    for (int a = 0; a < 2; ++a)
#pragma unroll
        for (int b = 0; b < 2; ++b)
#pragma unroll
            for (int m = 0; m < 4; ++m)
#pragma unroll
                for (int n = 0; n < 2; ++n) acc[a][b][m][n] = (f32x4){0.f, 0.f, 0.f, 0.f};
    bf16x8 At[4][2], B0[2][2], B1[2][2];
    const char* cA = (const char*)g.A + (size_t)cur.pm * tstep; const char* cB = (const char*)g.Bt + (size_t)cur.pn * tstep;
    S.a_ready(cur);
    if constexpr (SP2) {
        PG8_STAGE(PG8_SB(0, 0), cB, voffB); PG8_STAGE(PG8_SB(0, 1), cB + hstep, voffB); PG8_STAGE(PG8_SA(0, 0), cA, voffA); PG8_STAGE(PG8_SA(0, 1), cA + hstep, voffA);
        if (wr == 1) PG8_BAR;
        PG8_WAIT_V(2); PG8_BAR;
        PG8_STAGE(PG8_SB(1, 0), cB + kstep, voffB); PG8_STAGE(PG8_SA(1, 0), cA + kstep, voffA); PG8_STAGE(PG8_SB(1, 1), cB + hstep + kstep, voffB);
        PG8_WAIT_V(6); PG8_BAR;
    } else {
        PG8_STAGE(PG8_SB(0, 0), cB, voffB); PG8_STAGE(PG8_SA(0, 0), cA, voffA); PG8_STAGE(PG8_SB(0, 1), cB + hstep, voffB); PG8_STAGE(PG8_SA(0, 1), cA + hstep, voffA);
        if (wr == 1) PG8_BAR;
        PG8_WAIT_V(4); PG8_BAR;
        PG8_STAGE(PG8_SB(1, 0), cB + kstep, voffB); PG8_STAGE(PG8_SA(1, 0), cA + kstep, voffA); PG8_STAGE(PG8_SB(1, 1), cB + hstep + kstep, voffB);
        PG8_WAIT_V(6); PG8_BAR;
    }
    for (;;) {
        const bool has_next = S.next(ui + 1, nxt);
        const char* nA = has_next ? (const char*)g.A + (size_t)nxt.pm * tstep : cA; const char* nB = has_next ? (const char*)g.Bt + (size_t)nxt.pn * tstep : cB;
        for (int t = 0; t < nt; t += 2) {
            const bool last = (t == nt - 2);
            const char* a1 = cA + (size_t)(t + 1) * kstep;
            const char* a2 = last ? nA : cA + (size_t)(t + 2) * kstep; const char* b2 = last ? nB : cB + (size_t)(t + 2) * kstep;
            const char* a3 = a2 + kstep; const char* b3 = b2 + kstep;
            if (last && has_next) S.a_ready(nxt);
            if constexpr (SP2) {
            PG8_LDB(B0, 0, 0); PG8_LDB(B1, 0, 1); PG8_SCHED; PG8_LDA(At, 0, 0); PG8_STAGE(PG8_SA(1, 1), a1 + hstep, voffA);
            PG8_WAIT_V(8); PG8_WAIT_L(0); PG8_BAR; PG8_MMA(0, 0, At, B0); PG8_MMA(0, 1, At, B1); PG8_BAR; PG8_SCHED;
            PG8_LDA(At, 0, 1); PG8_STAGE(PG8_SB(0, 0), b2, voffB); PG8_STAGE(PG8_SB(0, 1), b2 + hstep, voffB); PG8_STAGE(PG8_SA(0, 0), a2, voffA);
            PG8_WAIT_V(8); PG8_WAIT_L(0); PG8_BAR; PG8_MMA(1, 0, At, B0); PG8_MMA(1, 1, At, B1); PG8_BAR; PG8_SCHED;
            PG8_LDB(B0, 1, 0); PG8_LDB(B1, 1, 1); PG8_SCHED; PG8_LDA(At, 1, 0); PG8_STAGE(PG8_SA(0, 1), a2 + hstep, voffA);
            PG8_WAIT_V(8); PG8_WAIT_L(0); PG8_BAR; PG8_MMA(0, 0, At, B0); PG8_MMA(0, 1, At, B1); PG8_BAR; PG8_SCHED;
            PG8_LDA(At, 1, 1); PG8_STAGE(PG8_SB(1, 0), b3, voffB); PG8_STAGE(PG8_SB(1, 1), b3 + hstep, voffB); PG8_STAGE(PG8_SA(1, 0), a3, voffA);
            PG8_WAIT_V(8); PG8_WAIT_L(0); PG8_BAR; PG8_MMA(1, 0, At, B0); PG8_MMA(1, 1, At, B1); PG8_BAR; PG8_SCHED;
            } else {
            PG8_LDB(B0, 0, 0); PG8_SCHED; PG8_LDA(At, 0, 0); PG8_STAGE(PG8_SA(1, 1), a1 + hstep, voffA);
            PG8_WAIT_L(8); PG8_BAR; PG8_WAIT_L(0); PG8_MMA(0, 0, At, B0); PG8_BAR; PG8_SCHED;
            PG8_LDB(B1, 0, 1); PG8_STAGE(PG8_SB(0, 0), b2, voffB);
            PG8_BAR; PG8_WAIT_L(0); PG8_MMA(0, 1, At, B1); PG8_BAR;
            PG8_LDA(At, 0, 1); PG8_STAGE(PG8_SA(0, 0), a2, voffA);
            PG8_BAR; PG8_WAIT_L(0); PG8_MMA(1, 0, At, B0); PG8_BAR; PG8_SCHED;
            PG8_STAGE(PG8_SB(0, 1), b2 + hstep, voffB);
            PG8_WAIT_V(6); PG8_BAR; PG8_MMA(1, 1, At, B1); PG8_BAR;
            PG8_LDB(B0, 1, 0); PG8_SCHED; PG8_LDA(At, 1, 0); PG8_STAGE(PG8_SA(0, 1), a2 + hstep, voffA);
            PG8_WAIT_L(8); PG8_BAR; PG8_WAIT_L(0); PG8_MMA(0, 0, At, B0); PG8_BAR; PG8_SCHED;
            PG8_LDB(B1, 1, 1); PG8_STAGE(PG8_SB(1, 0), b3, voffB);
            PG8_BAR; PG8_WAIT_L(0); PG8_MMA(0, 1, At, B1); PG8_BAR;
            PG8_LDA(At, 1, 1); PG8_STAGE(PG8_SA(1, 0), a3, voffA);
            PG8_BAR; PG8_WAIT_L(0); PG8_MMA(1, 0, At, B0); PG8_BAR; PG8_SCHED;
            PG8_STAGE(PG8_SB(1, 1), b3 + hstep, voffB);
            PG8_WAIT_V(6); PG8_BAR; PG8_MMA(1, 1, At, B1); PG8_BAR;
            }
        }
        if constexpr (ALIGN_EPI) { if (wr == 0) PG8_BAR; }
        if constexpr (!Epi::AFTER_DRAIN) { E(acc, cur, wr, wc, fr, fq); S.done(cur); }
        if (!has_next) break;
#pragma unroll
        for (int a = 0; a < 2; ++a)
#pragma unroll
            for (int b = 0; b < 2; ++b)
#pragma unroll
                for (int m = 0; m < 4; ++m)
#pragma unroll
                    for (int n = 0; n < 2; ++n) acc[a][b][m][n] = (f32x4){0.f, 0.f, 0.f, 0.f};
        cur = nxt; cA = nA; cB = nB; ++ui;
        if constexpr (ALIGN_EPI) { if (wr == 1) PG8_BAR; }
    }
    PG8_WAIT_V(0);
    if constexpr (!ALIGN_EPI) { if (wr == 0) PG8_BAR; }
    PG8_BAR;
    if constexpr (Epi::AFTER_DRAIN) { E.fused(acc, cur, wr, wc, fr, fq, lds, wid, lane); S.done(cur); }
#undef PG8_SA
#undef PG8_SB
#undef PG8_STAGE
#undef PG8_LDA
#undef PG8_LDB
#undef PG8_MMA
#undef PG8_WAIT_V
#undef PG8_WAIT_L
#undef PG8_BAR
#undef PG8_SCHED
}
}

DI unsigned* gate_ptr(const char* ws, int l, int k) { return (unsigned*)(ws + OFF_CTR) + 1024 + (l * 2 + k) * 320; }
DI void gate_arrive(unsigned* g, int tid, unsigned xcc, unsigned nloc) {
    asm volatile("s_waitcnt vmcnt(0)" ::: "memory");
    __syncthreads();
    if (tid == 0) {
        const unsigned old = xb_add(g + 16 * (xcc + 1), 1u);
        if (old + 1u == nloc) {
            __builtin_amdgcn_fence(__ATOMIC_RELEASE, "agent");
            asm volatile("s_waitcnt vmcnt(0)" ::: "memory");
            (void)xb_add(g, nloc);
        }
    }
}
DI bool gate_wait2(unsigned* g1, unsigned* g2, unsigned target, int tid, volatile int* slot) {
    if (tid == 0) {
        unsigned sp = 0;
        while (xb_ld(g1) < target) { __builtin_amdgcn_s_sleep(2); if (++sp > (1u << 24)) break; }
        slot[0] = (xb_ld(g2) >= target) ? 1 : 0;
        __builtin_amdgcn_fence(__ATOMIC_ACQUIRE, "agent");
        asm volatile("s_waitcnt vmcnt(0)" ::: "memory");
    }
    __syncthreads();
    return slot[0] != 0;
}
DI void gate_wait(unsigned* g, unsigned target, int tid) {
    if (tid == 0) {
        unsigned sp = 0;
        while (xb_ld(g) < target) { __builtin_amdgcn_s_sleep(2); if (++sp > (1u << 24)) break; }
        __builtin_amdgcn_fence(__ATOMIC_ACQUIRE, "agent");
        asm volatile("s_waitcnt vmcnt(0)" ::: "memory");
    }
    __syncthreads();
}

DI int inproj_srccol(int np) {
    const int pn = np >> 8, c = np & 255, bj = c >> 7, wc = (c & 127) >> 5, j = c & 31;
    const int nlog = pn * 256 + 64 * wc + 32 * bj + j;
    return nlog < 2048 ? nlog : nlog + 8;
}
template <int MODE>
DI void transpose_tile(const float* src, int lds_, int k0, const float* gk, const float* gn, short* dst, int ldd, int n0, float* tile, int tid) {
    __syncthreads();
    {
        const int n4 = (tid & 15) * 4, kq = tid >> 4;
        const int col = (MODE == 0) ? inproj_srccol(n0 + n4) : (n0 + n4);
        f32x4 gnv = {1.f, 1.f, 1.f, 1.f};
        if (gn) gnv = *(const f32x4*)(gn + n0 + n4);
#pragma unroll
        for (int i = 0; i < 2; ++i) {
            const int k = i * 32 + kq;
            f32x4 v = *(const f32x4*)(src + (size_t)(k0 + k) * lds_ + col);
            const float g = gk ? gk[k0 + k] : 1.f;
            v = v * gnv * g;
            tile[k * 65 + n4] = v[0]; tile[k * 65 + n4 + 1] = v[1]; tile[k * 65 + n4 + 2] = v[2]; tile[k * 65 + n4 + 3] = v[3];
        }
    }
    __syncthreads();
    {
        const int n = tid >> 3, k8 = (tid & 7) * 8;
        u32x4 o;
#pragma unroll
        for (int q = 0; q < 4; ++q) o[q] = pk2(tile[(k8 + 2 * q) * 65 + n], tile[(k8 + 2 * q + 1) * 65 + n]);
        *(u32x4*)(dst + (size_t)(n0 + n) * ldd + k0 + k8) = o;
    }
}

DI void convert_layer(const Params& p, int l, char* lds, int tid, int vb, int nb) {
    float* tile = (float*)lds;
    short* wtin = (short*)(p.ws + OFF_WTIN) + (size_t)l * NP * DM; short* wtout = (short*)(p.ws + OFF_WTOUT) + (size_t)l * DM * DM;
    short* wtpool = (short*)(p.ws + OFF_WTPOOL) + (size_t)l * 4 * 4096; short* wtff = (short*)(p.ws + OFF_WTFF) + (size_t)l * 16 * DM;
    for (int e = vb * NT + tid; e < 16 * DM; e += nb * NT) {
        const int f = e >> 10, k = e & (DM - 1);
        const float v = (f < 8) ? p.w_in[((size_t)l * DM + k) * DIN + 2048 + f] * p.norm_g[l * DM + k] : 0.f;
        wtff[e] = (short)(pk2(v, 0.f) & 0xffffu);
    }
    if (vb == 0 && tid < 64) {
        float gq = fabsf(p.qg[l * 64 + tid]), gk = fabsf(p.kg[l * 64 + tid]);
#pragma unroll
        for (int d = 32; d >= 1; d >>= 1) { gq = fmaxf(gq, __shfl_xor(gq, d)); gk = fmaxf(gk, __shfl_xor(gk, d)); }
        if (tid == 0) ((float*)(p.ws + OFF_CTR))[3968 + l] = 8.f * gq * gk * LOG2E * 1.02f + 0.25f;
    }
    constexpr int U_IN = 16 * 56, U_OUT = 16 * 16, U_POOL = 4;
    for (int u = vb; u < U_IN + U_OUT + U_POOL; u += nb) {
        if (u < U_IN) {
            const int ntile = u / 16, kt = u % 16;
            transpose_tile<0>(p.w_in + (size_t)l * DM * DIN, DIN, kt * 64, p.norm_g + l * DM, nullptr, wtin, DM, ntile * 64, tile, tid);
        } else if (u < U_IN + U_OUT) {
            const int v = u - U_IN; const int ntile = v / 16, kt = v % 16;
            transpose_tile<1>(p.w_out + (size_t)l * DM * DM, DM, kt * 64, nullptr, nullptr, wtout, DM, ntile * 64, tile, tid);
        } else {
            const int g = u - U_IN - U_OUT;
            transpose_tile<1>(p.w_pool + (size_t)(l * 4 + g) * 4096, 64, 0, nullptr, p.pool_scale + l * 256 + g * 64, wtpool + (size_t)g * 4096, 64, 0, tile, tid);
        }
    }
    __syncthreads();
}

DI void phase_prologue(const Params& p, char* lds, int tid) {
    if (blockIdx.x == 0 && tid < 16) ((unsigned*)(p.ws + OFF_CTR))[tid] = 0u;
    convert_layer(p, 0, lds, tid, (int)blockIdx.x, (int)gridDim.x);
    short* xb = (short*)(p.ws + OFF_XB); float* ssq = (float*)(p.ws + OFF_SSQ);
    const int lane = tid & 63, w = tid >> 6;
    for (int row = blockIdx.x * 8 + w; row < T; row += gridDim.x * 8) {
        const float* xr = p.x + (size_t)row * DM;
        float ss = 0.f;
#pragma unroll
        for (int j = 0; j < 4; ++j) {
            const f32x4 v = *(const f32x4*)(xr + j * 256 + lane * 4);
            ss += v[0] * v[0] + v[1] * v[1] + v[2] * v[2] + v[3] * v[3];
            u32x2 o = {pk2(v[0], v[1]), pk2(v[2], v[3])};
            *(u32x2*)(xb + (size_t)row * DM + j * 256 + lane * 4) = o;
        }
#pragma unroll
        for (int d = 32; d >= 1; d >>= 1) ss += __shfl_xor(ss, d);
        if (lane < 16) ssq[(size_t)row * 16 + lane] = (lane == 0) ? ss : 0.f;
    }
}

typedef float pf32x4 __attribute__((ext_vector_type(4)));
DI float row_rstd(const float* ssq, int row, int fq) {
    const f32x4 v = *(const f32x4*)(ssq + (size_t)row * 16 + 4 * fq);
    float s = (v[0] + v[1]) + (v[2] + v[3]);
    s += __shfl_xor(s, 16); s += __shfl_xor(s, 32);
    return __builtin_amdgcn_rsqf(s * (1.f / 1024.f) + EPS);
}
struct EpiIn {
    static constexpr bool PERM = true, AFTER_DRAIN = false;
    char* ws; const float* qg; const float* kg;
    DI void operator()(const pg8::f32x4 (&acc)[2][2][4][2], const pg8::Unit& u, int wr, int wc, int fr, int fq) const {
        asm volatile("" : "+v"(fr), "+v"(fq));
        const int pn = u.pn;
        const float* ssq = (const float*)(ws + OFF_SSQ);
        float rstdv[2][4];
        {
            f32x4 sv[2][4];
#pragma unroll
            for (int ai = 0; ai < 2; ++ai)
#pragma unroll
                for (int m = 0; m < 4; ++m) sv[ai][m] = *(const f32x4*)(ssq + (size_t)(u.pm * 256 + ai * 128 + wr * 64 + m * 16 + fr) * 16 + 4 * fq);
            PIN8(sv);
#pragma unroll
            for (int ai = 0; ai < 2; ++ai)
#pragma unroll
                for (int m = 0; m < 4; ++m) {
                    float sx = (sv[ai][m][0] + sv[ai][m][1]) + (sv[ai][m][2] + sv[ai][m][3]);
                    sx += __shfl_xor(sx, 16); sx += __shfl_xor(sx, 32);
                    rstdv[ai][m] = __builtin_amdgcn_rsqf(sx * (1.f / 1024.f) + EPS);
                }
        }
#pragma unroll
        for (int ai = 0; ai < 2; ++ai)
#pragma unroll
            for (int m = 0; m < 4; ++m) {
                const int row = u.pm * 256 + ai * 128 + wr * 64 + m * 16 + fr;
                const float rstd = rstdv[ai][m];
                const int b = row >> 12, s = row & 4095;
                if (pn < 4) {
                    float ss = 0.f;
#pragma unroll
                    for (int bj = 0; bj < 2; ++bj)
#pragma unroll
                        for (int n = 0; n < 2; ++n)
#pragma unroll
                            for (int c = 0; c < 4; ++c) { const float v = acc[ai][bj][m][n][c]; ss += v * v; }
                    ss += __shfl_xor(ss, 16); ss += __shfl_xor(ss, 32);
                    ss *= rstd * rstd;
                    const float rn = __builtin_amdgcn_rsqf(ss * (1.f / 64.f) + EPS) * rstd * (pn < 2 ? 0.125f * LOG2E : 1.f);
                    const float* gv = (pn < 2) ? qg : kg;
                    short* dst = (short*)(ws + (pn < 2 ? OFF_QF : OFF_KF)) + ((size_t)(b * 8 + (pn & 1) * 4 + wc) * S + s) * 64;
#pragma unroll
                    for (int bj = 0; bj < 2; ++bj) {
                        const int d = 32 * bj + 8 * fq;
                        const f32x4 g0 = *(const f32x4*)(gv + d), g1 = *(const f32x4*)(gv + d + 4);
                        const f32x4 v0 = acc[ai][bj][m][0] * (g0 * rn), v1 = acc[ai][bj][m][1] * (g1 * rn);
                        store8(dst + d, v0, v1);
                    }
                } else if (pn == 4 || pn == 5 || pn == 12) {
                    short* base = (pn == 12) ? ((short*)(ws + OFF_SVT) + ((size_t)(b * 4 + wc) * 64) * S)
                                             : ((short*)(ws + OFF_VTF) + ((size_t)(b * 8 + (pn - 4) * 4 + wc) * 64) * S);
#pragma unroll
                    for (int bj = 0; bj < 2; ++bj)
#pragma unroll
                        for (int n = 0; n < 2; ++n)
#pragma unroll
                            for (int c = 0; c < 4; c += 2) {
                                const int d = 32 * bj + 8 * fq + 4 * n + c;
                                const unsigned pk = pk2(acc[ai][bj][m][n][c] * rstd, acc[ai][bj][m][n][c + 1] * rstd);
                                base[(size_t)d * S + s] = (short)(pk & 0xffffu);
                                base[(size_t)(d + 1) * S + s] = (short)(pk >> 16);
                            }
                } else {
                    short* dst; bool dosilu = false; float sc = rstd;
                    if (pn == 6 || pn == 7) { dst = (short*)(ws + OFF_MIX) + (size_t)row * DM + (pn - 6) * 256 + wc * 64; }
                    else if (pn == 8) { dst = (short*)(ws + OFF_PX) + (size_t)row * 256 + wc * 64; }
                    else if (pn == 9) { dst = (short*)(ws + OFF_MIX) + (size_t)row * DM + 512 + wc * 64; }
                    else if (pn == 10) { dst = (short*)(ws + OFF_SQ) + ((size_t)(b * 4 + wc) * S + s) * 64; sc = rstd * 0.125f * LOG2E; }
                    else if (pn == 11) { dst = (short*)(ws + OFF_SK) + ((size_t)(b * 4 + wc) * S + s) * 64; }
                    else { dst = (short*)(ws + OFF_MIX) + (size_t)row * DM + 768 + wc * 64; }
#pragma unroll
                    for (int bj = 0; bj < 2; ++bj) {
                        f32x4 v0 = acc[ai][bj][m][0] * sc, v1 = acc[ai][bj][m][1] * sc;
                        if (dosilu) {
#pragma unroll
                            for (int c = 0; c < 4; ++c) { v0[c] = silu_f(v0[c]); v1[c] = silu_f(v1[c]); }
                        }
                        store8(dst + 32 * bj + 8 * fq, v0, v1);
                    }
                }
            }
    }
};
struct EpiOut {
    static constexpr bool PERM = true, AFTER_DRAIN = false;
    const float* res32; float* out; short* xb; float* ssq; int first; int last;
    DI void operator()(const pg8::f32x4 (&acc)[2][2][4][2], const pg8::Unit& u, int wr, int wc, int fr, int fq) const {
        asm volatile("" : "+v"(fr), "+v"(fq));
#pragma unroll
        for (int ai = 0; ai < 2; ++ai) {
            u32x4 rb[2][4];
            if (!first) {
#pragma unroll
                for (int m = 0; m < 4; ++m)
#pragma unroll
                    for (int bj = 0; bj < 2; ++bj)
                        rb[bj][m] = *(const u32x4*)(xb + (size_t)(u.pm * 256 + ai * 128 + wr * 64 + m * 16 + fr) * DM + u.pn * 256 + bj * 128 + wc * 32 + fq * 8);
                PIN8(rb);
            }
#pragma unroll
            for (int m = 0; m < 4; ++m) {
                const int row = u.pm * 256 + ai * 128 + wr * 64 + m * 16 + fr;
                float ss = 0.f;
#pragma unroll
                for (int bj = 0; bj < 2; ++bj) {
                    const size_t off = (size_t)row * DM + u.pn * 256 + bj * 128 + wc * 32 + fq * 8;
                    f32x4 r0, r1;
                    if (first) { r0 = *(const f32x4*)(res32 + off); r1 = *(const f32x4*)(res32 + off + 4); }
                    else {
                        const u32x4 rv = rb[bj][m];
                        r0 = (f32x4){bf_lo(rv[0]), bf_hi(rv[0]), bf_lo(rv[1]), bf_hi(rv[1])}; r1 = (f32x4){bf_lo(rv[2]), bf_hi(rv[2]), bf_lo(rv[3]), bf_hi(rv[3])};
                    }
                    const f32x4 o0 = r0 + acc[ai][bj][m][0], o1 = r1 + acc[ai][bj][m][1];
                    if (last) { *(f32x4*)(out + off) = o0; *(f32x4*)(out + off + 4) = o1; }
                    else {
                        ss += (o0[0] * o0[0] + o0[1] * o0[1]) + (o0[2] * o0[2] + o0[3] * o0[3]) + (o1[0] * o1[0] + o1[1] * o1[1]) + (o1[2] * o1[2] + o1[3] * o1[3]);
                        store8(xb + off, o0, o1);
                    }
                }
                if (!last) { ss += __shfl_xor(ss, 16); ss += __shfl_xor(ss, 32); if (fq == 0) ssq[(size_t)row * 16 + u.pn * 4 + wc] = ss; }
            }
        }
    }
};

DI void ff_job(const Params& p, int l, int tb, int tid) {
    const int lane = tid & 63, w = tid >> 6, fr = lane & 15, fq = lane >> 4;
    const int tok = tb * 128 + w * 16 + fr;
    const short* wff = (const short*)(p.ws + OFF_WTFF) + (size_t)l * 16 * DM + fr * DM + fq * 8;
    const short* xr = (const short*)(p.ws + OFF_XB) + (size_t)tok * DM + fq * 8;
    pg8::f32x4 acc = {0.f, 0.f, 0.f, 0.f};
#pragma unroll 16
    for (int ks = 0; ks < 32; ++ks) {
        const bf16x8 a = *(const bf16x8*)(wff + ks * 32), bq = *(const bf16x8*)(xr + ks * 32);
        acc = __builtin_amdgcn_mfma_f32_16x16x32_bf16(a, bq, acc, 0, 0, 0);
    }
    const float* sp = (const float*)(p.ws + OFF_SSQ) + (size_t)tok * 16;
    const f32x4 s0 = *(const f32x4*)sp, s1 = *(const f32x4*)(sp + 4), s2 = *(const f32x4*)(sp + 8), s3 = *(const f32x4*)(sp + 12);
    const float ssum = ((s0[0] + s0[1]) + (s0[2] + s0[3])) + ((s1[0] + s1[1]) + (s1[2] + s1[3])) + ((s2[0] + s2[1]) + (s2[2] + s2[3])) + ((s3[0] + s3[1]) + (s3[2] + s3[3]));
    const float rstd = __builtin_amdgcn_rsqf(ssum * (1.f / 1024.f) + EPS);
    if (fq < 2) {
        const int b = tok >> 12, s = tok & 4095;
        float* LOGF = (float*)(p.ws + OFF_LOGF);
#pragma unroll
        for (int i = 0; i < 4; ++i) {
            const int f = 4 * fq + i;
            const float v = acc[i] * rstd + p.b_f[l * 8 + f];
            LOGF[(size_t)(b * 8 + f) * S + s] = fminf(v, 0.f) - log1pf(expf(-fabsf(v)));
        }
    }
}

struct InSchedA {
    pg8::StaticOrder s;
    __device__ bool next(int i, pg8::Unit& u) const { if (!s.next(i, u)) return false; u.pn = (u.pn < 9) ? u.pn : u.pn + 1; return true; }
    DI void a_ready(const pg8::Unit&) const {}
    DI void done(const pg8::Unit&) const {}
};
struct InSchedB {
    pg8::StaticOrder s;
    __device__ bool next(int i, pg8::Unit& u) const { if (!s.next(i, u)) return false; u.pn = u.pn ? 13 : 9; return true; }
    DI void a_ready(const pg8::Unit&) const {}
    DI void done(const pg8::Unit&) const {}
};
DI void phase_inproj(const Params& p, int l, char* lds, int tid, unsigned xcc, unsigned nloc) {
    const int G = gridDim.x, c = (int)blockIdx.x;
    for (int tb = G - 1 - c; tb < 128; tb += G) ff_job(p, l, tb, tid);
    pg8::Gemm g{(const pg8::bf16_t*)(p.ws + OFF_XB), (const pg8::bf16_t*)(p.ws + OFF_WTIN) + (size_t)l * NP * DM, T, NP, DM};
    EpiIn E{p.ws, p.qg + l * 64, p.kg + l * 64};
    { InSchedA Sa; Sa.s.init(T, 12 * 256, G, c); pg8::gemm_phase<EpiIn, InSchedA, true, true>((PG8_LAS unsigned char*)lds, g, Sa, E); }
    InSchedB Sb; Sb.s.init(T, 2 * 256, G, c);
    pg8::Unit u0; u0.pm = 0; u0.pn = 0;
    const bool has_last = Sb.next(0, u0);
    gate_arrive(gate_ptr(p.ws, l, 0), tid, xcc, nloc);
    if (has_last) {
        pg8::gemm_phase<EpiIn, InSchedB, true, true>((PG8_LAS unsigned char*)lds, g, Sb, E);
        gate_arrive(gate_ptr(p.ws, l, 1), tid, xcc, nloc);
    } else if (tid == 0) {
        unsigned* g2p = gate_ptr(p.ws, l, 1);
        const unsigned old2 = xb_add(g2p + 16 * (xcc + 1), 1u);
        if (old2 + 1u == nloc) { __builtin_amdgcn_fence(__ATOMIC_RELEASE, "agent"); asm volatile("s_waitcnt vmcnt(0)" ::: "memory"); (void)xb_add(g2p, nloc); }
    }
}
DI void phase_outproj(const Params& p, int l, char* lds, int tid) {
    const int G = gridDim.x;
    pg8::Gemm g{(const pg8::bf16_t*)(p.ws + OFF_MIX), (const pg8::bf16_t*)(p.ws + OFF_WTOUT) + (size_t)l * DM * DM, T, DM, DM};
    pg8::StaticOrder So; So.init(T, DM, G, (int)blockIdx.x);
    EpiOut E{p.x, p.out, (short*)(p.ws + OFF_XB), (float*)(p.ws + OFF_SSQ), (l == 0) ? 1 : 0, (l + 1 == NL) ? 1 : 0};
    pg8::gemm_phase<EpiOut, pg8::StaticOrder, true, true>((PG8_LAS unsigned char*)lds, g, So, E);
}

constexpr int STG_BYTES = 16384, RING_OFF = 16384;
DI void glds16(const void* gsrc, unsigned lds_dst) {
    unsigned keep;
    asm volatile("s_mov_b32 %0, m0\n\ts_mov_b32 m0, %2\n\ts_nop 0\n\tglobal_load_lds_dwordx4 %1, off\n\ts_mov_b32 m0, %0" : "=&s"(keep) : "v"(gsrc), "s"(lds_dst) : "memory");
}
DI void kv_dma(const short* Kb, const short* Vtb, int j, char* stage, int tid) {
    const int w = tid >> 6, row = tid >> 3, ch = (tid & 7) ^ ((row >> 1) & 7);
    const unsigned dst = (unsigned)__builtin_amdgcn_readfirstlane((int)(unsigned)(size_t)(LAS char*)stage + w * 1024);
    glds16(Kb + (size_t)(64 * j + row) * 64 + ch * 8, dst);
    glds16(Vtb + (size_t)row * S + 64 * j + ch * 8, dst + 8192u);
}
DI void kv_wait_bar(int rem) {
    if (rem >= 2) asm volatile("s_waitcnt vmcnt(4)\n\ts_waitcnt lgkmcnt(0)\n\ts_barrier" ::: "memory");
    else if (rem == 1) asm volatile("s_waitcnt vmcnt(2)\n\ts_waitcnt lgkmcnt(0)\n\ts_barrier" ::: "memory");
    else asm volatile("s_waitcnt vmcnt(0)\n\ts_waitcnt lgkmcnt(0)\n\ts_barrier" ::: "memory");
}

DI void fox_qk(const char* kb, const float* cp, const bf16x8 (&qf)[4], float bt, int krow, int hi, f32x16 (&sacc)[2]) {
    bf16x8 kf[2][4];
#pragma unroll
    for (int sub = 0; sub < 2; ++sub)
#pragma unroll
        for (int kk = 0; kk < 4; ++kk) kf[sub][kk] = *(const bf16x8*)(kb + swz(32 * sub + krow, 2 * kk + hi));
    f32x4 cv[2][4];
#pragma unroll
    for (int sub = 0; sub < 2; ++sub)
#pragma unroll
        for (int q4 = 0; q4 < 4; ++q4) cv[sub][q4] = *(const f32x4*)(cp + 32 * sub + 4 * q4);
    PIN8(kf); PIN8(cv);
#pragma unroll
    for (int sub = 0; sub < 2; ++sub)
#pragma unroll
        for (int q4 = 0; q4 < 4; ++q4) {
            sacc[sub][4 * q4] = bt - cv[sub][q4][0]; sacc[sub][4 * q4 + 1] = bt - cv[sub][q4][1]; sacc[sub][4 * q4 + 2] = bt - cv[sub][q4][2]; sacc[sub][4 * q4 + 3] = bt - cv[sub][q4][3];
        }
    __builtin_amdgcn_s_setprio(1);
#pragma unroll
    for (int kk = 0; kk < 4; ++kk)
#pragma unroll
        for (int sub = 0; sub < 2; ++sub) sacc[sub] = MFMA32(kf[sub][kk], qf[kk], sacc[sub]);
    __builtin_amdgcn_s_setprio(0);
}
template <bool MASK>
DI void fox_sm(const f32x16 (&sacc)[2], int lim, float& lsum, bf16x8 (&pf)[2][2]) {
#pragma unroll
    for (int sub = 0; sub < 2; ++sub) {
        float pr[16];
#pragma unroll
        for (int i = 0; i < 16; ++i) {
            float pv = fexp2(sacc[sub][i]);
            if (MASK) { if (i + 32 * sub > lim) pv = 0.f; }
            pr[i] = pv;
        }
        pf[sub][0] = pack8(pr[0], pr[1], pr[2], pr[3], pr[4], pr[5], pr[6], pr[7]);
        pf[sub][1] = pack8(pr[8], pr[9], pr[10], pr[11], pr[12], pr[13], pr[14], pr[15]);
    }
}
DI void fox_pv(const char* vb, int r, int hi, const bf16x8 (&pf)[2][2], f32x16 (&oacc)[2], f32x16& lacc) {
    bf16x8 vf[2][4];
#pragma unroll
    for (int mi = 0; mi < 2; ++mi)
#pragma unroll
        for (int c = 0; c < 4; ++c) vf[mi][c] = *(const bf16x8*)(vb + swz(32 * mi + r, 4 * (c >> 1) + 2 * hi + (c & 1)));
    PIN8(vf);
    const u32x4 onesu = {0x3f803f80u, 0x3f803f80u, 0x3f803f80u, 0x3f803f80u};
    const bf16x8 ones = __builtin_bit_cast(bf16x8, onesu);
    __builtin_amdgcn_s_setprio(1);
#pragma unroll
    for (int c = 0; c < 4; ++c) {
#pragma unroll
        for (int mi = 0; mi < 2; ++mi) oacc[mi] = MFMA32(vf[mi][c], pf[c >> 1][c & 1], oacc[mi]);
        lacc = MFMA32(ones, pf[c >> 1][c & 1], lacc);
    }
    __builtin_amdgcn_s_setprio(0);
}
DI void fox_unit(const Params& p, int l, int bh, int qb, char* lds, int tid) {
    const int lane = tid & 63, w = tid >> 6, r = lane & 31, hi = lane >> 5;
    float* cs = (float*)lds; char* ring = lds + RING_OFF; float* misc = (float*)(lds + LDS_MISC);
    const short* Kb = (const short*)(p.ws + OFF_KF) + (size_t)bh * S * 64;
    const short* Vtb = (const short*)(p.ws + OFF_VTF) + (size_t)bh * 64 * S;
    const int kmax = (qb + 1) * 256, jmax = 4 * qb + 3;
    kv_dma(Kb, Vtb, jmax, ring, tid);
    const float M2 = ((const float*)(p.ws + OFF_CTR))[3968 + l];
    const int qrow = qb * 256 + w * 32 + r;
    bf16x8 qf[4];
    {
        const short* qp = (const short*)(p.ws + OFF_QF) + ((size_t)bh * S + qrow) * 64 + hi * 8;
#pragma unroll
        for (int kk = 0; kk < 4; ++kk) qf[kk] = *(const bf16x8*)(qp + kk * 16);
    }
    {
        const float* lf = (const float*)(p.ws + OFF_LOGF) + (size_t)bh * S + tid * 8;
        float v[8];
        if (tid * 8 < kmax) {
#pragma unroll
            for (int q = 0; q < 2; ++q) { const f32x4 t4 = *(const f32x4*)(lf + 4 * q); v[4 * q] = t4[0]; v[4 * q + 1] = t4[1]; v[4 * q + 2] = t4[2]; v[4 * q + 3] = t4[3]; }
        } else {
#pragma unroll
            for (int q = 0; q < 8; ++q) v[q] = 0.f;
        }
#pragma unroll
        for (int q = 1; q < 8; ++q) v[q] += v[q - 1];
        const float tot = v[7];
        float sc = tot;
#pragma unroll
        for (int d = 1; d < 64; d <<= 1) { const float t2 = __shfl_up(sc, d); if (lane >= d) sc += t2; }
        if (lane == 63) misc[w] = sc;
        __syncthreads();
        float off = sc - tot;
        for (int j = 0; j < w; ++j) off += misc[j];
#pragma unroll
        for (int q = 0; q < 8; ++q) cs[tid * 8 + q] = (off + v[q]) * LOG2E;
    }
    __syncthreads();
    int jlo = 0;
#if FOX_SKIP
    {
        const float cq = cs[qb * 256];
        const bool c = (lane <= jmax) && (cq - cs[64 * lane + 63] < -(152.f + 2.f * M2));
        const unsigned long long mask = __ballot(c);
        jlo = mask ? (64 - __builtin_clzll(mask)) : 0;
        if (jlo > jmax) jlo = jmax;
    }
#endif
    int jloww = jlo;
#if FOX_SKIP
    {
        const float cqw = cs[qb * 256 + w * 32];
        const bool c2 = (lane <= jmax) && (cqw - cs[64 * lane + 63] < -(152.f + 2.f * M2));
        const unsigned long long mask2 = __ballot(c2);
        jloww = mask2 ? (64 - __builtin_clzll(mask2)) : 0;
        const int jdiag = (qb * 256 + w * 32) >> 6;
        if (jloww > jdiag) jloww = jdiag;
        if (jloww < jlo) jloww = jlo;
    }
#endif
    float bt = cs[qrow] - M2;
    asm volatile("" : "+v"(qf[0]), "+v"(qf[1]), "+v"(qf[2]), "+v"(qf[3]), "+v"(bt));
    asm volatile("s_waitcnt vmcnt(0)" ::: "memory");
#pragma unroll
    for (int t = 1; t < 4; ++t) if (jmax - t >= jlo) kv_dma(Kb, Vtb, jmax - t, ring + t * STG_BYTES, tid);
    f32x16 oacc[2];
#pragma unroll
    for (int mi = 0; mi < 2; ++mi)
#pragma unroll
        for (int i = 0; i < 16; ++i) oacc[mi][i] = 0.f;
    float lsum = 0.f;
    f32x16 lacc;
#pragma unroll
    for (int i = 0; i < 16; ++i) lacc[i] = 0.f;
    const int qmin = qb * 256 + w * 32;
    const int krow = 16 * ((r >> 2) & 1) + 4 * (r >> 3) + (r & 3);
    const int ntl = jmax - jlo + 1;
    const int nch = (ntl + 1) >> 1;
    for (int c = 0; c < nch; ++c) {
        const int nnext = (2 * c + 3 < ntl) ? 2 : ((2 * c + 2 < ntl) ? 1 : 0);
        kv_wait_bar(nnext);
        {
            const int t0 = 2 * c + 4;
            if (t0 < ntl) kv_dma(Kb, Vtb, jmax - t0, ring + (t0 % 6) * STG_BYTES, tid);
            if (t0 + 1 < ntl) kv_dma(Kb, Vtb, jmax - t0 - 1, ring + ((t0 + 1) % 6) * STG_BYTES, tid);
        }
#pragma unroll
        for (int h2 = 0; h2 < 2; ++h2) {
            const int t = 2 * c + h2;
            const int key0 = 64 * (jmax - t);
            if (t < ntl && key0 <= qmin + 31 && (jmax - t) >= jloww) {
                const char* stg = ring + (t % 6) * STG_BYTES;
                f32x16 sc[2];
                fox_qk(stg, cs + key0 + 16 * hi, qf, bt, krow, hi, sc);
                bf16x8 pf[2][2];
                if (key0 + 63 > qmin) fox_sm<true>(sc, qrow - key0 - 16 * hi, lsum, pf); else fox_sm<false>(sc, 0, lsum, pf);
                fox_pv(stg + 8192, r, hi, pf, oacc, lacc);
            }
        }
    }
    lsum = lacc[0];
    const float inv = __builtin_amdgcn_rcpf(lsum);
    const int b = bh >> 3, h = bh & 7;
    short* mp = (short*)(p.ws + OFF_MIX) + (size_t)(b * S + qrow) * DM + h * 64;
#pragma unroll
    for (int mi = 0; mi < 2; ++mi)
#pragma unroll
        for (int g = 0; g < 4; ++g) {
            const int d = 32 * mi + 8 * g + 4 * hi;
            const u32x2 gv = *(const u32x2*)(mp + d);
            store4(mp + d, oacc[mi][4 * g] * inv * silu_f(bf_lo(gv[0])), oacc[mi][4 * g + 1] * inv * silu_f(bf_hi(gv[0])), oacc[mi][4 * g + 2] * inv * silu_f(bf_lo(gv[1])), oacc[mi][4 * g + 3] * inv * silu_f(bf_hi(gv[1])));
        }
}

template <bool MASK>
DI void sb_tile(const char* kb, const bf16x8 (&qf)[4], int krow, int r, int hi, int lim, f32x16 (&oacc)[2], float& Rc) {
    const char* vb = kb + 8192;
    bf16x8 kf[2][4];
#pragma unroll
    for (int sub = 0; sub < 2; ++sub)
#pragma unroll
        for (int kk = 0; kk < 4; ++kk) kf[sub][kk] = *(const bf16x8*)(kb + swz(32 * sub + krow, 2 * kk + hi));
    PIN8(kf);
    f32x16 z[2];
#pragma unroll
    for (int sub = 0; sub < 2; ++sub) {
#pragma unroll
        for (int i = 0; i < 16; ++i) z[sub][i] = 0.f;
#pragma unroll
        for (int kk = 0; kk < 4; ++kk) z[sub] = MFMA32(kf[sub][kk], qf[kk], z[sub]);
    }
    bf16x8 vf[2][4];
#pragma unroll
    for (int mi = 0; mi < 2; ++mi)
#pragma unroll
        for (int c = 0; c < 4; ++c) vf[mi][c] = *(const bf16x8*)(vb + swz(32 * mi + r, 4 * (c >> 1) + 2 * hi + (c & 1)));
    PIN8(vf);
    float Tt[2];
#pragma unroll
    for (int sub = 1; sub >= 0; --sub) {
        float run = 0.f;
#pragma unroll
        for (int i = 15; i >= 0; --i) {
            const float zz = z[sub][i];
            const float e = fexp2(-fabsf(zz));
            float sp = fmaxf(zz, 0.f) + flog2(1.f + e);
            float val = zz + (run - sp);
            if (MASK) { if (i + 32 * sub >= lim) { sp = 0.f; val = -INFINITY; } }
            z[sub][i] = val;
            run -= sp;
        }
        Tt[sub] = run;
    }
    const float T1p = __shfl_xor(Tt[1], 32), T0p = __shfl_xor(Tt[0], 32);
    const float sum1 = Tt[1] + T1p;
    float off[2];
    off[1] = Rc + (hi == 0 ? T1p : 0.f);
    off[0] = Rc + sum1 + (hi == 0 ? T0p : 0.f);
    Rc = Rc + sum1 + Tt[0] + T0p;
    bf16x8 pf[2][2];
#pragma unroll
    for (int sub = 0; sub < 2; ++sub) {
        float pr[16];
#pragma unroll
        for (int i = 0; i < 16; ++i) pr[i] = fexp2(z[sub][i] + off[sub]);
        pf[sub][0] = pack8(pr[0], pr[1], pr[2], pr[3], pr[4], pr[5], pr[6], pr[7]);
        pf[sub][1] = pack8(pr[8], pr[9], pr[10], pr[11], pr[12], pr[13], pr[14], pr[15]);
    }
#pragma unroll
    for (int c = 0; c < 4; ++c)
#pragma unroll
        for (int mi = 0; mi < 2; ++mi) oacc[mi] = MFMA32(vf[mi][c], pf[c >> 1][c & 1], oacc[mi]);
}

DI void sb_unit(const Params& p, int bh, int qb, char* lds, int tid) {
    const int lane = tid & 63, w = tid >> 6, r = lane & 31, hi = lane >> 5;
    char* ring = lds + RING_OFF; volatile int* flags = (volatile int*)(lds + LDS_MISC + 256);
    const short* Kb = (const short*)(p.ws + OFF_SK) + (size_t)bh * S * 64;
    const short* Vtb = (const short*)(p.ws + OFF_SVT) + (size_t)bh * 64 * S;
    const int jmax = 4 * qb + 3;
    const int qrow = qb * 256 + w * 32 + r;
    const int nwin = (jmax + 1 < 8) ? (jmax + 1) : 8;
#pragma unroll
    for (int t = 0; t < 8; ++t) if (t < nwin) kv_dma(Kb, Vtb, jmax - t, lds + t * STG_BYTES, tid);
    bf16x8 qf[4];
    {
        const short* qp = (const short*)(p.ws + OFF_SQ) + ((size_t)bh * S + qrow) * 64 + hi * 8;
#pragma unroll
        for (int kk = 0; kk < 4; ++kk) qf[kk] = *(const bf16x8*)(qp + kk * 16);
    }
    asm volatile("" : "+v"(qf[0]), "+v"(qf[1]), "+v"(qf[2]), "+v"(qf[3]));
    f32x16 oacc[2];
#pragma unroll
    for (int mi = 0; mi < 2; ++mi)
#pragma unroll
        for (int i = 0; i < 16; ++i) oacc[mi][i] = 0.f;
    float Rc = 0.f;
    const int qmin = qb * 256 + w * 32;
    const int krow = 16 * ((r >> 2) & 1) + 4 * (r >> 3) + (r & 3);
    asm volatile("s_waitcnt vmcnt(0)\n\ts_barrier" ::: "memory");
    const int tw = 3 - (w >> 1);
    bool wdone = false;
    for (int t = 0; t < nwin; ++t) {
        if (t >= tw && !wdone) {
            const int key0 = 64 * (jmax - t);
            const char* kb = lds + t * STG_BYTES;
            if (key0 + 63 >= qmin) sb_tile<true>(kb, qf, krow, r, hi, qrow - key0 - 16 * hi, oacc, Rc);
            else sb_tile<false>(kb, qf, krow, r, hi, 0, oacc, Rc);
            wdone = __all(Rc < -152.f);
        }
    }
    if (lane == 0) flags[16 + w] = wdone ? 1 : 0;
    __syncthreads();
    int ndw = 0;
#pragma unroll
    for (int q = 0; q < 8; ++q) ndw += flags[16 + q];
    const int jstart = jmax - 8;
    if (ndw < 8 && jstart >= 0) {
#pragma unroll
        for (int t = 0; t < 3; ++t) if (jstart - t >= 0) kv_dma(Kb, Vtb, jstart - t, ring + t * STG_BYTES, tid);
        int it = 0;
        for (int j = jstart; j >= 0; --j, ++it) {
            const int cur = it & 1;
            kv_wait_bar(j);
            if (j >= 3) kv_dma(Kb, Vtb, j - 3, ring + ((it + 3) & 3) * STG_BYTES, tid);
            if (it > 0) {
                int nd = 0;
#pragma unroll
                for (int q = 0; q < 8; ++q) nd += flags[(cur ^ 1) * 8 + q];
                if (nd == 8) break;
            }
            if (!wdone) {
                sb_tile<false>(ring + (it & 3) * STG_BYTES, qf, krow, r, hi, 0, oacc, Rc);
                wdone = __all(Rc < -152.f);
            }
            if (lane == 0) flags[cur * 8 + w] = wdone ? 1 : 0;
        }
        asm volatile("s_waitcnt vmcnt(0)" ::: "memory");
    }
    const int b = bh >> 2, h = bh & 3;
    short* mp = (short*)(p.ws + OFF_MIX) + (size_t)(b * S + qrow) * DM + 768 + h * 64;
#pragma unroll
    for (int mi = 0; mi < 2; ++mi)
#pragma unroll
        for (int g = 0; g < 4; ++g) {
            const int d = 32 * mi + 8 * g + 4 * hi;
            const u32x2 gv = *(const u32x2*)(mp + d);
            store4(mp + d, oacc[mi][4 * g] * silu_f(bf_lo(gv[0])), oacc[mi][4 * g + 1] * silu_f(bf_hi(gv[0])), oacc[mi][4 * g + 2] * silu_f(bf_lo(gv[1])), oacc[mi][4 * g + 3] * silu_f(bf_hi(gv[1])));
        }
    __syncthreads();
}

template <int G>
DI void pool_group(const Params& p, int l, int tok0, char* lds, int tid) {
    const int lane = tid & 63, w = tid >> 6, r = lane & 31, hi = lane >> 5;
    constexpr int wlen = 2 << G;
    const int tl = w * 32 + r, token = tok0 + tl, s = token & 4095;
    const short* px = (const short*)(p.ws + OFF_PX);
    const short* wp = (const short*)(p.ws + OFF_WTPOOL) + (size_t)(l * 4 + G) * 4096;
    short* mp = (short*)(p.ws + OFF_MIX) + (size_t)token * DM + 512 + G * 64;
    __syncthreads();
#pragma unroll
    for (int i = 0; i < 5; ++i) {
        const int c = tid + NT * i;
        if (c < 271 * 8) {
            const int row = c >> 3, ch = c & 7, tok = tok0 - 15 + row;
            u32x4 v = {0u, 0u, 0u, 0u};
            if (tok >= 0) v = *(const u32x4*)(px + (size_t)tok * 256 + G * 64 + ch * 8);
            *(u32x4*)(lds + swz(row, ch)) = v;
        }
    }
    __syncthreads();
    const int cnt = (s + 1 < wlen) ? (s + 1) : wlen;
    const float icnt = 1.f / (float)cnt;
    f32x16 oacc[2];
#pragma unroll
    for (int mi = 0; mi < 2; ++mi)
#pragma unroll
        for (int i = 0; i < 16; ++i) oacc[mi][i] = 0.f;
#pragma unroll 1
    for (int kk = 0; kk < 4; ++kk) {
        float sum[8], x0[8];
        {
            const u32x4 v = *(const u32x4*)(lds + swz(tl + 15, 2 * kk + hi));
#pragma unroll
            for (int q = 0; q < 4; ++q) { x0[2 * q] = bf_lo(v[q]); x0[2 * q + 1] = bf_hi(v[q]); sum[2 * q] = x0[2 * q]; sum[2 * q + 1] = x0[2 * q + 1]; }
        }
#pragma unroll
        for (int jj = 1; jj < wlen; ++jj) {
            const u32x4 v = *(const u32x4*)(lds + swz(tl + 15 - jj, 2 * kk + hi));
            const bool ok = jj < cnt;
#pragma unroll
            for (int q = 0; q < 4; ++q) { sum[2 * q] += ok ? bf_lo(v[q]) : 0.f; sum[2 * q + 1] += ok ? bf_hi(v[q]) : 0.f; }
        }
        const bf16x8 pfr = pack8(sum[0] * icnt - x0[0], sum[1] * icnt - x0[1], sum[2] * icnt - x0[2], sum[3] * icnt - x0[3],
                                 sum[4] * icnt - x0[4], sum[5] * icnt - x0[5], sum[6] * icnt - x0[6], sum[7] * icnt - x0[7]);
#pragma unroll
        for (int mi = 0; mi < 2; ++mi) {
            const bf16x8 wf = *(const bf16x8*)(wp + (32 * mi + r) * 64 + kk * 16 + hi * 8);
            oacc[mi] = MFMA32(wf, pfr, oacc[mi]);
        }
    }
#pragma unroll
    for (int mi = 0; mi < 2; ++mi)
#pragma unroll
        for (int gg = 0; gg < 4; ++gg) {
            const int d = 32 * mi + 8 * gg + 4 * hi;
            const u32x2 gv = *(const u32x2*)(mp + d);
            store4(mp + d, oacc[mi][4 * gg] * silu_f(bf_lo(gv[0])), oacc[mi][4 * gg + 1] * silu_f(bf_hi(gv[0])), oacc[mi][4 * gg + 2] * silu_f(bf_lo(gv[1])), oacc[mi][4 * gg + 3] * silu_f(bf_hi(gv[1])));
        }
}
DI void pool_unit(const Params& p, int l, int tt, char* lds, int tid) {
    pool_group<0>(p, l, tt * 256, lds, tid); pool_group<1>(p, l, tt * 256, lds, tid);
    pool_group<2>(p, l, tt * 256, lds, tid); pool_group<3>(p, l, tt * 256, lds, tid);
    __syncthreads();
}

DI void phase_mixers(const Params& p, int l, char* lds, int tid) {
    unsigned* ctr = (unsigned*)(p.ws + OFF_CTR) + l;
    volatile int* su = (volatile int*)(lds + LDS_MISC + 512);
    constexpr int U_FOX = 32 * 16, U_SB = 16 * 16, U_POOL = 64, U_CONV = 72;
    const int nconv = (l + 1 < NL) ? U_CONV : 0;
    bool g1 = false, g2 = false;
    for (;;) {
        __syncthreads();
        asm volatile("" : "+v"(tid));
        if (tid == 0) su[0] = (int)__hip_atomic_fetch_add(ctr, 1u, __ATOMIC_RELAXED, __HIP_MEMORY_SCOPE_AGENT);
        __syncthreads();
        int u = su[0];
        if (u >= U_FOX + U_SB + U_POOL + nconv) break;
        if (u >= U_FOX + U_SB + U_POOL) { convert_layer(p, l + 1, lds, tid, u - (U_FOX + U_SB + U_POOL), U_CONV); continue; }
        constexpr int FSPLIT = 5, U_F1 = 32 * (16 - FSPLIT);
        if (u >= U_F1 && u < U_FOX + U_SB) u = (u < U_F1 + U_SB) ? (u - U_F1 + U_FOX) : (u - U_SB);
        if (u < U_FOX) { if (!g1) { g2 = gate_wait2(gate_ptr(p.ws, l, 0), gate_ptr(p.ws, l, 1), gridDim.x, tid, su + 3); g1 = true; } }
        else if (!g2) { gate_wait(gate_ptr(p.ws, l, 1), gridDim.x, tid); g1 = true; g2 = true; }
        if (u < U_FOX) fox_unit(p, l, u & 31, 15 - (u >> 5), lds, tid);
        else if (u < U_FOX + U_SB) { const int v = u - U_FOX; sb_unit(p, v & 15, 15 - (v >> 4), lds, tid); }
        else pool_unit(p, l, u - U_FOX - U_SB, lds, tid);
    }
}

__global__ void __launch_bounds__(NT, 2) mega(Params p, int ph_lo, int ph_hi) {
    extern __shared__ __attribute__((aligned(16))) char lds[];
    const int tid0 = threadIdx.x;
    if (p.use_cg) cg::this_grid().sync();
    XcdBarrier bar;
    volatile LAS unsigned* xbw = (volatile LAS unsigned*)(lds + LDS_MISC + 1024);
    if (ph_hi - ph_lo > 1) {
        if (tid0 < 4) xbw[tid0] = 0u;
        __syncthreads();
        bar = xcd_barrier_post((unsigned*)(p.ws + OFF_BAR), xbw);
    }
    for (int ph = ph_lo; ph < ph_hi; ++ph) {
        int tid = tid0; asm volatile("" : "+v"(tid));
        if (ph == 0) phase_prologue(p, lds, tid);
        else {
            const int l = (ph - 1) / 3, k = (ph - 1) % 3;
            if (k == 0) phase_inproj(p, l, lds, tid, bar.x, xbw[0]);
            else if (k == 1) phase_mixers(p, l, lds, tid);
            else phase_outproj(p, l, lds, tid);
        }
        if (ph + 1 < ph_hi && !(ph > 0 && (ph - 1) % 3 == 0)) {
            unsigned long long bp = (unsigned long long)(p.ws + OFF_BAR); asm volatile("" : "+s"(bp));
            bar.bar = (unsigned*)bp;
            xcd_barrier(bar);
        }
    }
}

extern "C" void kernel_launch(void* const* d_in, const int* in_sizes, int n_in, void* d_out, int out_size, void* d_ws, size_t ws_size, hipStream_t stream) {
    Params p{};
    p.x = (const float*)d_in[0]; p.norm_g = (const float*)d_in[1]; p.w_in = (const float*)d_in[2]; p.b_f = (const float*)d_in[3];
    p.qg = (const float*)d_in[4]; p.kg = (const float*)d_in[5]; p.w_pool = (const float*)d_in[6]; p.pool_scale = (const float*)d_in[7];
    p.w_out = (const float*)d_in[8]; p.out = (float*)d_out; p.ws = (char*)d_ws; p.use_cg = 0; p.pad = 0;
    if (ws_size < WS_NEED) { fprintf(stderr, "workspace too small: %zu < %zu\n", ws_size, WS_NEED); return; }
    static bool attr_set = false;
    if (!attr_set) {
        if (hipFuncSetAttribute((const void*)mega, hipFuncAttributeMaxDynamicSharedMemorySize, LDS_TOTAL) != hipSuccess) fprintf(stderr, "hipFuncSetAttribute failed\n");
        attr_set = true;
    }
    const int grid = 256;
    constexpr int NPH = 1 + 3 * NL;
    (void)hipMemsetAsync(d_ws, 0, 32768, stream);
    int lo = 0, hi = NPH;
    void* args[] = {&p, &lo, &hi};
    hipError_t e = hipLaunchCooperativeKernel((const void*)mega, dim3(grid), dim3(NT), args, LDS_TOTAL, stream);
    if (e != hipSuccess) fprintf(stderr, "cooperative launch failed: %s\n", hipGetErrorString(e));
}
```
